# Optimizing an MI355X kernel written in HIP

```python
import math
import jax, jax.numpy as jnp
from jax import lax
import numpy as np

D_MODEL = 1024
BATCH = 16
SEQ = 2048
DEPTH = 2

CHUNK = 64
Q_BLOCK = 128
N_MIXERS = 4
GROUP_WIDTH = D_MODEL // N_MIXERS
HEAD_DIM = 64
HEADS_PER_GROUP = GROUP_WIDTH // HEAD_DIM
CONV_WIDTH = 3
SGU_BLOCK = 128
PROJ_WIDTH = 11 * GROUP_WIDTH + HEADS_PER_GROUP
N_EXPERT_GROUPS = 4
EXPERTS_PER_GROUP = 8
N_EXPERTS = N_EXPERT_GROUPS * EXPERTS_PER_GROUP
TOP_K = 2
D_EXPERT = D_MODEL // 4
ROW_BLOCK = 256
ALPHA = (2.0 * DEPTH) ** 0.25
BETA = (8.0 * DEPTH) ** -0.25
LN_EPS = 1e-5
RMS_EPS = 1e-6

kernel_name = "chunk_causal_hybrid_headgroup_moe_encoder"


def layer_norm(x, g, b):
    xf = x.astype(jnp.float32)
    mu = jnp.mean(xf, axis=-1, keepdims=True)
    var = jnp.mean(jnp.square(xf - mu), axis=-1, keepdims=True)
    y = (xf - mu) * lax.rsqrt(var + LN_EPS) * g.astype(jnp.float32) + b.astype(jnp.float32)
    return y.astype(x.dtype)


def group_rms_norm(x, g):
    B, S, D = x.shape
    xf = x.astype(jnp.float32).reshape(B, S, N_MIXERS, GROUP_WIDTH)
    xf = xf * lax.rsqrt(jnp.mean(jnp.square(xf), axis=-1, keepdims=True) + RMS_EPS)
    return (xf.reshape(B, S, D) * g.astype(jnp.float32)).astype(x.dtype)


def to_heads(t):
    B, S, _ = t.shape
    return t.reshape(B, S, HEADS_PER_GROUP, HEAD_DIM).transpose(0, 2, 1, 3)


def from_heads(t):
    B, H, S, d = t.shape
    return t.transpose(0, 2, 1, 3).reshape(B, S, H * d)


def stick_breaking_attention(q, k, v):
    B, H, S, d = q.shape
    nq = S // Q_BLOCK
    qb = q.reshape(B, H, nq, Q_BLOCK, d).transpose(2, 0, 1, 3, 4)
    k_pos = jnp.arange(S)
    scale = 1.0 / math.sqrt(d)

    def block(args):
        q_blk, i = args
        z = jnp.einsum('bhqd,bhkd->bhqk', q_blk, k).astype(jnp.float32) * scale
        q_pos = i * Q_BLOCK + jnp.arange(Q_BLOCK)
        mask = k_pos[None, :] < q_pos[:, None]
        log_1m = jnp.where(mask, jax.nn.log_sigmoid(-z), 0.0)
        later = lax.cumsum(log_1m, axis=3, reverse=True) - log_1m
        w = jnp.where(mask, jnp.exp(jax.nn.log_sigmoid(z) + later), 0.0)
        return jnp.einsum('bhqk,bhkd->bhqd', w.astype(v.dtype), v)

    out = lax.map(block, (qb, jnp.arange(nq)))
    return out.transpose(1, 2, 0, 3, 4).reshape(B, H, S, d)


def forgetting_attention(q, k, v, log_f):
    B, H, S, d = q.shape
    nq = S // Q_BLOCK
    c = lax.cumsum(log_f, axis=2)
    qb = q.reshape(B, H, nq, Q_BLOCK, d).transpose(2, 0, 1, 3, 4)
    cb = c.reshape(B, H, nq, Q_BLOCK).transpose(2, 0, 1, 3)
    k_pos = jnp.arange(S)
    scale = 1.0 / math.sqrt(d)
    neg = jnp.finfo(jnp.float32).min

    def block(args):
        q_blk, c_blk, i = args
        s = jnp.einsum('bhqd,bhkd->bhqk', q_blk, k).astype(jnp.float32) * scale
        s = s + c_blk[..., :, None] - c[:, :, None, :]
        q_pos = i * Q_BLOCK + jnp.arange(Q_BLOCK)
        mask = k_pos[None, :] <= q_pos[:, None]
        p = jax.nn.softmax(jnp.where(mask, s, neg), axis=-1)
        return jnp.einsum('bhqk,bhkd->bhqd', p.astype(v.dtype), v)

    out = lax.map(block, (qb, cb, jnp.arange(nq)))
    return out.transpose(1, 2, 0, 3, 4).reshape(B, H, S, d)


def short_gated_conv(h, b_gate, c_gate, conv_w, conv_b):
    S = h.shape[1]
    z = c_gate * h
    zp = jnp.pad(z, ((0, 0), (CONV_WIDTH - 1, 0), (0, 0)))
    y = conv_b + conv_w[0] * zp[:, 0:S]
    for tap in range(1, CONV_WIDTH):
        y = y + conv_w[tap] * zp[:, tap:tap + S]
    return b_gate * y


def spatial_gating(u, v, ln_g, ln_b, w_s, b_s):
    v = layer_norm(v, ln_g, ln_b)
    B, S, W = v.shape
    nb = S // SGU_BLOCK
    vb = v.reshape(B, nb, SGU_BLOCK, HEADS_PER_GROUP, HEAD_DIM)
    chunk_id = jnp.arange(SGU_BLOCK) // CHUNK
    mask = chunk_id[None, :] <= chunk_id[:, None]
    w_m = jnp.where(mask[None], w_s, 0.0).astype(v.dtype)
    mixed = jnp.einsum('gij,bnjgc->bnigc', w_m, vb) + b_s.T[None, None, :, :, None]
    return u * mixed.reshape(B, S, W)


def mixer_sublayer(x, w_in, b_f, conv_w, conv_b, sgu_ln_g, sgu_ln_b, sgu_w, sgu_b, grp_g, w_out):
    W = GROUP_WIDTH
    proj = x @ w_in
    qkv_a, qkv_b, f_b, conv_in, sgu_in = jnp.split(
        proj, [3 * W, 6 * W, 6 * W + HEADS_PER_GROUP, 9 * W + HEADS_PER_GROUP], axis=-1)
    qa, ka, va = jnp.split(qkv_a, 3, axis=-1)
    out_a = from_heads(stick_breaking_attention(to_heads(qa), to_heads(ka), to_heads(va)))
    qb, kb, vb = jnp.split(qkv_b, 3, axis=-1)
    log_f = jax.nn.log_sigmoid(f_b.astype(jnp.float32) + b_f.astype(jnp.float32)).transpose(0, 2, 1)
    out_b = from_heads(forgetting_attention(to_heads(qb), to_heads(kb), to_heads(vb), log_f))
    h_c, b_c, c_c = jnp.split(conv_in, 3, axis=-1)
    out_c = short_gated_conv(h_c, b_c, c_c, conv_w, conv_b)
    u_d, v_d = jnp.split(jax.nn.gelu(sgu_in), 2, axis=-1)
    out_d = spatial_gating(u_d, v_d, sgu_ln_g, sgu_ln_b, sgu_w, sgu_b)
    mix = group_rms_norm(jnp.concatenate([out_a, out_b, out_c, out_d], axis=-1), grp_g)
    return mix @ w_out


def hierarchical_moe(x, router_g_w, router_g_b, router_e_w, router_e_b, w1, w3, w2):
    Bsz, S, D = x.shape
    xf = x.reshape(-1, D)
    T = xf.shape[0]
    p_g = jax.nn.softmax((xf @ router_g_w).astype(jnp.float32) + router_g_b.astype(jnp.float32), axis=-1)
    g_sel = jnp.argmax(p_g, axis=-1)
    p_gsel = jnp.take_along_axis(p_g, g_sel[:, None], axis=-1)
    e_logits = ((xf @ router_e_w).astype(jnp.float32) + router_e_b.astype(jnp.float32)).reshape(
        T, N_EXPERT_GROUPS, EXPERTS_PER_GROUP)
    e_in = jnp.take_along_axis(e_logits, g_sel[:, None, None], axis=1)[:, 0]
    top_p, top_i = lax.top_k(jax.nn.softmax(e_in, axis=-1), TOP_K)
    gate = p_gsel * top_p / jnp.sum(top_p, axis=-1, keepdims=True)
    expert = g_sel[:, None] * EXPERTS_PER_GROUP + top_i

    A = T * TOP_K
    e_flat = expert.reshape(-1)
    tok_flat = jnp.repeat(jnp.arange(T, dtype=jnp.int32), TOP_K)
    w_flat = gate.reshape(-1)
    order = jnp.argsort(e_flat)
    e_s, tok_s, w_s = e_flat[order], tok_flat[order], w_flat[order]
    counts = jax.ops.segment_sum(jnp.ones((A,), jnp.int32), e_flat, num_segments=N_EXPERTS)
    starts = jnp.cumsum(counts) - counts
    padded = (counts + ROW_BLOCK - 1) // ROW_BLOCK * ROW_BLOCK
    p_ends = jnp.cumsum(padded)
    p_starts = p_ends - padded
    dest = p_starts[e_s] + jnp.arange(A, dtype=jnp.int32) - starts[e_s]
    P = -(-A // ROW_BLOCK) * ROW_BLOCK + N_EXPERTS * ROW_BLOCK
    n_blocks = P // ROW_BLOCK
    tok_pad = jnp.zeros((P,), jnp.int32).at[dest].set(tok_s)
    w_pad = jnp.zeros((P,), jnp.float32).at[dest].set(w_s)
    block_expert = jnp.clip(jnp.searchsorted(p_ends, jnp.arange(n_blocks) * ROW_BLOCK, side='right'),
                            0, N_EXPERTS - 1)
    xs = xf[tok_pad].reshape(n_blocks, ROW_BLOCK, D)

    def expert_block(args):
        xb, e = args
        h = jax.nn.silu(xb @ w1[e]) * (xb @ w3[e])
        return h @ w2[e]

    ys = lax.map(expert_block, (xs, block_expert)).reshape(P, D)
    y = jax.ops.segment_sum(ys * w_pad[:, None].astype(ys.dtype), tok_pad, num_segments=T)
    return y.reshape(Bsz, S, D)


def setup_inputs(seed: int = 0) -> dict:
    key = jax.random.key(seed)
    ks = jax.random.split(key, 24)
    f32 = jnp.float32
    n = lambda k, shape: jax.random.normal(k, shape, f32)
    D, W, G, L = D_MODEL, GROUP_WIDTH, HEADS_PER_GROUP, DEPTH
    return {
        "x": n(ks[0], (BATCH, SEQ, D)),
        "ln_in_g": 1.0 + 0.02 * n(ks[1], (D,)),
        "ln_in_b": 0.02 * n(ks[2], (D,)),
        "w_in": n(ks[3], (L, D, PROJ_WIDTH)) * D ** -0.5,
        "b_f": 2.0 + 0.5 * n(ks[4], (L, G)),
        "conv_w": 0.5 * n(ks[5], (L, CONV_WIDTH, W)),
        "conv_b": 0.02 * n(ks[6], (L, W)),
        "sgu_ln_g": 1.0 + 0.02 * n(ks[7], (L, W)),
        "sgu_ln_b": 0.02 * n(ks[8], (L, W)),
        "sgu_w": n(ks[9], (L, G, SGU_BLOCK, SGU_BLOCK)) * SGU_BLOCK ** -0.5,
        "sgu_b": 1.0 + 0.02 * n(ks[10], (L, G, SGU_BLOCK)),
        "grp_g": 1.0 + 0.02 * n(ks[11], (L, D)),
        "w_out": n(ks[12], (L, D, D)) * D ** -0.5 * BETA,
        "ln1_g": 1.0 + 0.02 * n(ks[13], (L, D)),
        "ln1_b": 0.02 * n(ks[14], (L, D)),
        "router_g_w": n(ks[15], (L, D, N_EXPERT_GROUPS)) * D ** -0.5,
        "router_g_b": 0.01 * n(ks[16], (L, N_EXPERT_GROUPS)),
        "router_e_w": n(ks[17], (L, D, N_EXPERTS)) * D ** -0.5,
        "router_e_b": 0.01 * n(ks[18], (L, N_EXPERTS)),
        "w1": n(ks[19], (L, N_EXPERTS, D, D_EXPERT)) * D ** -0.5,
        "w3": n(ks[20], (L, N_EXPERTS, D, D_EXPERT)) * D ** -0.5,
        "w2": n(ks[21], (L, N_EXPERTS, D_EXPERT, D)) * D_EXPERT ** -0.5 * BETA,
        "ln2_g": 1.0 + 0.02 * n(ks[22], (L, D)),
        "ln2_b": 0.02 * n(ks[23], (L, D)),
    }


def reference(x, ln_in_g, ln_in_b, w_in, b_f, conv_w, conv_b, sgu_ln_g, sgu_ln_b, sgu_w, sgu_b,
              grp_g, w_out, ln1_g, ln1_b, router_g_w, router_g_b, router_e_w, router_e_b,
              w1, w3, w2, ln2_g, ln2_b):
    x = layer_norm(x, ln_in_g, ln_in_b)
    for i in range(DEPTH):
        mixed = mixer_sublayer(x, w_in[i], b_f[i], conv_w[i], conv_b[i], sgu_ln_g[i], sgu_ln_b[i],
                               sgu_w[i], sgu_b[i], grp_g[i], w_out[i])
        x = layer_norm(ALPHA * x + mixed, ln1_g[i], ln1_b[i])
        ffn = hierarchical_moe(x, router_g_w[i], router_g_b[i], router_e_w[i], router_e_b[i],
                               w1[i], w3[i], w2[i])
        x = layer_norm(ALPHA * x + ffn, ln2_g[i], ln2_b[i])
    return x
```

```cpp
#ifndef MK_PH_HI
#define MK_PH_HI 1000
#endif
#ifndef MK_XP
#define MK_XP 0
#endif
#ifndef MK_XR
#define MK_XR 1
#endif
#ifndef MK_STAGGER_TICKS
#define MK_STAGGER_TICKS 1200
#endif
#ifndef MK_NT_STORE
#define MK_NT_STORE 0
#endif
#ifndef MK_AMODE
#define MK_AMODE 0
#endif
#ifndef MK_ROUTER_LO
#define MK_ROUTER_LO 0
#endif
#ifndef MK_RMODE
#define MK_RMODE 0
#endif
#ifndef MK_ULO
#define MK_ULO 0
#define MK_UHI 1000000
#endif
#include <hip/hip_runtime.h>
#include <cstdio>
#include <cstdint>
#include <cmath>

constexpr int D = 1024, NB = 16, S = 2048, T = NB * S, NL = 2;
constexpr int GW = 256, NH = 4, HD = 64, PWIN = 2820, NPROJ = 2816;
constexpr int NE = 32, DE = 256, ECAP = 65536, PMAX = 73728;
constexpr float LN_EPS = 1e-5f, RMS_EPS = 1e-6f;
constexpr float ALPHA = 1.4142135623730951f;
constexpr float LOG2E = 1.4426950408889634f;
constexpr float C2 = 0.125f * LOG2E;

namespace pg8 {
#define PG8_LAS __attribute__((address_space(3)))
typedef unsigned short bf16_t;
typedef short bf16x8 __attribute__((ext_vector_type(8)));
typedef float f32x4 __attribute__((ext_vector_type(4)));
typedef float f32x2 __attribute__((ext_vector_type(2)));
typedef unsigned u32x4 __attribute__((ext_vector_type(4)));
constexpr int BM = 256, BK = 64, HALF = 128, HTB = HALF * BK * 2, STAGE_BYTES = 8 * HTB, NXCD = 8, WGM = 8;

__host__ __device__ __forceinline__ int lds_byte(int r, int c) { const int st = (r >> 4) * 2 + (c >> 5), rr = r & 15, cc = c & 31, ob = rr * 64 + cc * 2; return st * 1024 + (ob ^ (((ob >> 9) & 1) << 5)); }
__host__ __device__ __forceinline__ void stage_rc(int b, int& R, int& C) { const int st = b / 1024, sb = b % 1024, swz = sb ^ (((sb >> 9) & 1) << 5); R = (st >> 1) * 16 + swz / 64; C = (st & 1) * 32 + (swz % 64) / 2; }
__host__ __device__ __forceinline__ int perm32(int rho) { const int n = rho >> 4, i = rho & 15; return 8 * (i >> 2) + 4 * n + (i & 3); }

struct Unit { int pm, pn; const char* a; const char* b; const int* rows; int nrows; int dep, sig; };

__device__ __forceinline__ unsigned cvt_pk_bf16(float lo, float hi) { unsigned r; asm volatile("v_cvt_pk_bf16_f32 %0, %1, %2" : "=v"(r) : "v"(lo), "v"(hi)); return r; }

struct StaticOrder {
    int nM, nN, nwg, G, c; const char* A; const char* Bt; size_t tstep;
    __device__ void init(const void* A_, const void* Bt_, int M, int N, int K, int G_, int c_) { nM = M / BM; nN = N / BM; nwg = nM * nN; G = G_; c = c_; A = (const char*)A_; Bt = (const char*)Bt_; tstep = (size_t)BM * K * 2; }
    __device__ bool next(int i, Unit& u) const {
        const long L = (long)i * G + c; if (L >= nwg) return false;
        int wgid = (int)L; { const int q = nwg / NXCD, r = nwg % NXCD, xcd = wgid % NXCD, off = wgid / NXCD; wgid = (xcd < r ? xcd * (q + 1) : r * (q + 1) + (xcd - r) * q) + off; }
        const int nig = WGM * nN, gid = wgid / nig, fm = gid * WGM, gsz = (nM - fm) < WGM ? (nM - fm) : WGM;
        u.pm = fm + ((wgid % nig) % gsz); u.pn = (wgid % nig) / gsz; u.a = A + (size_t)u.pm * tstep; u.b = Bt + (size_t)u.pn * tstep; u.rows = nullptr; u.nrows = BM; u.dep = 0; u.sig = 0; return true;
    }
    static constexpr bool HOOKS = false;
    __device__ __forceinline__ void a_ready(const Unit&) const {}
    __device__ __forceinline__ void done(const Unit&) const {}
};

template <class Epi, class Sched, bool GATHER, bool ALIGN_EPI = true>
__device__ __forceinline__ void gemm_phase(PG8_LAS unsigned char* lds, const int K, const Sched& S, const Epi& E, const int tid) {
    const int wid = __builtin_amdgcn_readfirstlane(tid >> 6), lane = tid & 63, wr = wid >> 2, wc = wid & 3, fr = lane & 15, fq = lane >> 4;
    const int nt = K / BK;
    unsigned voffA[2][2], voffB[2];
#pragma unroll
    for (int i = 0; i < 2; ++i) { int R, C; stage_rc(tid * 16 + i * 8192, R, C); const int Rb = Epi::PERM ? ((R & ~31) + perm32(R & 31)) : R;
        voffA[0][i] = (unsigned)(R * K + C) * 2u; voffA[1][i] = (unsigned)((R + HALF) * K + C) * 2u; voffB[i] = (unsigned)(Rb * K + C) * 2u; }
    const size_t kstep = (size_t)(BK * 2);
    const size_t hstep = (size_t)HALF * K * 2;
    const unsigned ldsw = (unsigned)wid * 1024u;
    const int aoff = lds_byte(wr * 64 + fr, fq * 8), boff = lds_byte(wc * 32 + fr, fq * 8);
#define PG8_SA(b, h) (((b) * 2 + (h)) * HTB)
#define PG8_SB(b, h) ((4 + (b) * 2 + (h)) * HTB)
#define PG8_STAGE(bufoff, gbase, voff) do { _Pragma("unroll") for (int _i = 0; _i < 2; ++_i) \
        __builtin_amdgcn_global_load_lds((const unsigned*)((const char*)(gbase) + (voff)[_i]), (PG8_LAS unsigned*)(lds + (bufoff) + ldsw + _i * 8192), 16, 0, 0); } while (0)
#define PG8_LDA(dst, b, h) do { _Pragma("unroll") for (int m = 0; m < 4; ++m) _Pragma("unroll") for (int k = 0; k < 2; ++k) dst[m][k] = *(const PG8_LAS bf16x8*)(lds + PG8_SA(b, h) + aoff + m * 2048 + k * 1024); } while (0)
#define PG8_LDB(dst, b, h) do { _Pragma("unroll") for (int n = 0; n < 2; ++n) _Pragma("unroll") for (int k = 0; k < 2; ++k) dst[n][k] = *(const PG8_LAS bf16x8*)(lds + PG8_SB(b, h) + boff + n * 2048 + k * 1024); } while (0)
#define PG8_MMA(ai, bj, At, Bt) do { __builtin_amdgcn_s_setprio(1); _Pragma("unroll") for (int m = 0; m < 4; ++m) _Pragma("unroll") for (int n = 0; n < 2; ++n) _Pragma("unroll") for (int k = 0; k < 2; ++k) \
        acc[ai][bj][m][n] = __builtin_amdgcn_mfma_f32_16x16x32_bf16(Bt[n][k], At[m][k], acc[ai][bj][m][n], 0, 0, 0); __builtin_amdgcn_s_setprio(0); } while (0)
#define PG8_WAIT_V(n) asm volatile("s_waitcnt vmcnt(" #n ")" ::: "memory")
#define PG8_WAIT_L(n) asm volatile("s_waitcnt lgkmcnt(" #n ")" ::: "memory")
#define PG8_BAR __builtin_amdgcn_s_barrier()
#define PG8_SCHED __builtin_amdgcn_sched_barrier(0)
#define PG8_GLOAD(ids, u) do { int _t2 = tid; asm volatile("" : "+v"(_t2)); _Pragma("unroll") for (int _i = 0; _i < 2; ++_i) { int _R, _C; stage_rc(_t2 * 16 + _i * 8192, _R, _C); \
        _Pragma("unroll") for (int _h = 0; _h < 2; ++_h) { const int _r = _R + _h * HALF; ids[_h][_i] = (_r < (u).nrows) ? (u).rows[_r] : 0; } } } while (0)
#define PG8_GSET(dst, ids) do { int _t2 = tid; asm volatile("" : "+v"(_t2)); _Pragma("unroll") for (int _i = 0; _i < 2; ++_i) { int _R, _C; stage_rc(_t2 * 16 + _i * 8192, _R, _C); \
        _Pragma("unroll") for (int _h = 0; _h < 2; ++_h) dst[_h][_i] = (unsigned)(ids[_h][_i] * K + _C) * 2u; } } while (0)
    Unit cur, nxt; int ui = 0;
    if (!S.next(0, cur)) return;
    f32x4 acc[2][2][4][2];
#pragma unroll
    for (int a = 0; a < 2; ++a)
#pragma unroll
        for (int b = 0; b < 2; ++b)
#pragma unroll
            for (int m = 0; m < 4; ++m)
#pragma unroll
                for (int n = 0; n < 2; ++n) acc[a][b][m][n] = (f32x4){0.f, 0.f, 0.f, 0.f};
    bf16x8 At[4][2], B0[2][2], B1[2][2];
    const char* cA = cur.a; const char* cB = cur.b;
    if constexpr (Sched::HOOKS) S.a_ready(cur);
    int gids[2][2];
    if constexpr (GATHER) { PG8_GLOAD(gids, cur); PG8_GSET(voffA, gids); }
    PG8_STAGE(PG8_SB(0, 0), cB, voffB); PG8_STAGE(PG8_SB(0, 1), cB + hstep, voffB); PG8_STAGE(PG8_SA(0, 0), cA, voffA[0]); PG8_STAGE(PG8_SA(0, 1), cA, voffA[1]);
    if (wr == 1) PG8_BAR;
    PG8_WAIT_V(2); PG8_BAR;
    PG8_STAGE(PG8_SB(1, 0), cB + kstep, voffB); PG8_STAGE(PG8_SA(1, 0), cA + kstep, voffA[0]); PG8_STAGE(PG8_SB(1, 1), cB + hstep + kstep, voffB);
    PG8_WAIT_V(6); PG8_BAR;
    for (;;) {
        const bool has_next = S.next(ui + 1, nxt);
        if constexpr (Epi::KSCALE) E.kscale_begin(cur, tid);
        if constexpr (GATHER) { if (has_next) { PG8_GLOAD(gids, nxt); } }
        const char* nA = has_next ? nxt.a : cA; const char* nB = has_next ? nxt.b : cB;
#pragma nounroll
        for (int t = 0; t < nt; t += 2) {
            const bool last = (t == nt - 2);
            const char* a1 = cA + (size_t)(t + 1) * kstep;
            const char* a2 = last ? nA : cA + (size_t)(t + 2) * kstep; const char* b2 = last ? nB : cB + (size_t)(t + 2) * kstep;
            const char* a3 = a2 + kstep; const char* b3 = b2 + kstep;
            if constexpr (Sched::HOOKS) { if (last && has_next) S.a_ready(nxt); }
            PG8_LDB(B0, 0, 0); PG8_LDB(B1, 0, 1); PG8_SCHED; PG8_LDA(At, 0, 0); PG8_STAGE(PG8_SA(1, 1), a1, voffA[1]);
            if constexpr (GATHER) { if (last && has_next) { PG8_GSET(voffA, gids); } }
            PG8_WAIT_V(8); PG8_WAIT_L(0); PG8_BAR; PG8_MMA(0, 0, At, B0); PG8_MMA(0, 1, At, B1); PG8_BAR; PG8_SCHED;
            PG8_LDA(At, 0, 1); PG8_STAGE(PG8_SB(0, 0), b2, voffB); PG8_STAGE(PG8_SB(0, 1), b2 + hstep, voffB); PG8_STAGE(PG8_SA(0, 0), a2, voffA[0]);
            PG8_WAIT_V(8); PG8_WAIT_L(0); PG8_BAR; PG8_MMA(1, 0, At, B0); PG8_MMA(1, 1, At, B1); PG8_BAR; PG8_SCHED;
            PG8_LDB(B0, 1, 0); PG8_LDB(B1, 1, 1); PG8_SCHED; PG8_LDA(At, 1, 0); PG8_STAGE(PG8_SA(0, 1), a2, voffA[1]);
            PG8_WAIT_V(8); PG8_WAIT_L(0); PG8_BAR; PG8_MMA(0, 0, At, B0); PG8_MMA(0, 1, At, B1); PG8_BAR; PG8_SCHED;
            PG8_LDA(At, 1, 1); PG8_STAGE(PG8_SB(1, 0), b3, voffB); PG8_STAGE(PG8_SB(1, 1), b3 + hstep, voffB); PG8_STAGE(PG8_SA(1, 0), a3, voffA[0]);
            PG8_WAIT_V(8); PG8_WAIT_L(0); PG8_BAR; PG8_MMA(1, 0, At, B0); PG8_MMA(1, 1, At, B1); PG8_BAR; PG8_SCHED;
            if constexpr (Epi::KSCALE) { if (t == 2 || t == 6) { PG8_SCHED; E.kscale(acc, t == 6 ? 1 : 0, wr, fr); PG8_SCHED; } }
        }
        if constexpr (ALIGN_EPI) { if (wr == 0) PG8_BAR; }
        E(acc, cur, wr, wc, fr, fq);
        if constexpr (Sched::HOOKS) S.done(cur);
        if (!has_next) break;
#pragma unroll
        for (int a = 0; a < 2; ++a)
#pragma unroll
            for (int b = 0; b < 2; ++b)
#pragma unroll
                for (int m = 0; m < 4; ++m)
#pragma unroll
                    for (int n = 0; n < 2; ++n) acc[a][b][m][n] = (f32x4){0.f, 0.f, 0.f, 0.f};
        cur = nxt; cA = nA; cB = nB; ++ui;
        if constexpr (ALIGN_EPI) { if (wr == 1) PG8_BAR; }
    }
    PG8_WAIT_V(0);
    if constexpr (!ALIGN_EPI) { if (wr == 0) PG8_BAR; }
    PG8_BAR;
#undef PG8_SA
#undef PG8_SB
#undef PG8_STAGE
#undef PG8_LDA
#undef PG8_LDB
#undef PG8_MMA
#undef PG8_WAIT_V
#undef PG8_WAIT_L
#undef PG8_BAR
#undef PG8_SCHED
#undef PG8_GLOAD
#undef PG8_GSET
}
}
#define GAS __attribute__((address_space(1)))
#define LAS __attribute__((address_space(3)))
typedef unsigned short bf16;
typedef unsigned v4u __attribute__((ext_vector_type(4)));
typedef unsigned v2u __attribute__((ext_vector_type(2)));
typedef float f32x4 __attribute__((ext_vector_type(4)));
typedef float f32x2 __attribute__((ext_vector_type(2)));
typedef float f32x16 __attribute__((ext_vector_type(16)));
typedef short bf16x8 __attribute__((ext_vector_type(8)));
typedef short s16x4 __attribute__((ext_vector_type(4)));
typedef GAS unsigned gu32;
#define RLX_AGENT __ATOMIC_RELAXED, __HIP_MEMORY_SCOPE_AGENT
#define LDS_WAIT() asm volatile("s_waitcnt lgkmcnt(0)" ::: "memory")
#define VM_WAIT() asm volatile("s_waitcnt vmcnt(0)" ::: "memory")
__device__ __forceinline__ unsigned f2bf(float f) { unsigned u = __builtin_bit_cast(unsigned, f); return (u + 0x7fffu + ((u >> 16) & 1u)) >> 16; }
typedef __bf16 bf16x2_t __attribute__((ext_vector_type(2)));
__device__ __forceinline__ unsigned pk2(float lo, float hi) { f32x2 v = {lo, hi}; bf16x2_t b = __builtin_convertvector(v, bf16x2_t); return __builtin_bit_cast(unsigned, b); }
__device__ __forceinline__ float bf2f(unsigned h) { return __builtin_bit_cast(float, h << 16); }
__device__ __forceinline__ float bflo(unsigned w) { return __builtin_bit_cast(float, w << 16); }
__device__ __forceinline__ float bfhi(unsigned w) { return __builtin_bit_cast(float, w & 0xffff0000u); }
template <int CTRL> __device__ __forceinline__ float dpp_mov(float v) { return __int_as_float(__builtin_amdgcn_update_dpp(0, __float_as_int(v), CTRL, 0xF, 0xF, true)); }
__device__ __forceinline__ float wave_sum(float v) {
    v += dpp_mov<0xB1>(v); v += dpp_mov<0x4E>(v); v += dpp_mov<0x141>(v); v += dpp_mov<0x140>(v);
    { auto s = __builtin_amdgcn_permlane16_swap(__float_as_uint(v), __float_as_uint(v), false, false); v = __uint_as_float(s[0]) + __uint_as_float(s[1]); }
    { auto s = __builtin_amdgcn_permlane32_swap(__float_as_uint(v), __float_as_uint(v), false, false); v = __uint_as_float(s[0]) + __uint_as_float(s[1]); }
    return v;
}
__device__ __forceinline__ float wave_max(float v) {
    v = fmaxf(v, dpp_mov<0xB1>(v)); v = fmaxf(v, dpp_mov<0x4E>(v)); v = fmaxf(v, dpp_mov<0x141>(v)); v = fmaxf(v, dpp_mov<0x140>(v));
    { auto s = __builtin_amdgcn_permlane16_swap(__float_as_uint(v), __float_as_uint(v), false, false); v = fmaxf(__uint_as_float(s[0]), __uint_as_float(s[1])); }
    { auto s = __builtin_amdgcn_permlane32_swap(__float_as_uint(v), __float_as_uint(v), false, false); v = fmaxf(__uint_as_float(s[0]), __uint_as_float(s[1])); }
    return v;
}
__device__ __forceinline__ float other_half(float x) {
    auto rr = __builtin_amdgcn_permlane32_swap(__float_as_uint(x), __float_as_uint(x), false, false);
    return __uint_as_float((threadIdx.x & 32) ? rr[0] : rr[1]);
}
__device__ __forceinline__ float log_sigmoid_f(float x) { return fminf(x, 0.f) - log1pf(__expf(-fabsf(x))); }
__device__ __forceinline__ float gelu_tanh_f(float x) {
    const float u = x * (1.0f + 0.044715f * x * x);
    const float e = __builtin_amdgcn_exp2f(u * (-2.0f * 0.7978845608028654f * LOG2E));
    return x * __builtin_amdgcn_rcpf(1.0f + e);
}

#if MK_NT_STORE
#define MK_STORE16(p, v) __builtin_nontemporal_store((v), (p))
#else
#define MK_STORE16(p, v) (*(p) = (v))
#endif
struct EpiProj {
    static constexpr bool PERM = true, KSCALE = false; static constexpr int NSTORE = 16;
    bf16* O; unsigned* kinf;
    __device__ __forceinline__ void operator()(const pg8::f32x4 (&acc)[2][2][4][2], const pg8::Unit& u, int wr, int wc, int fr, int fq) const {
        const int row0 = u.pm * 256 + wr * 64 + fr, col0 = u.pn * 256 + wc * 32 + 8 * fq;
        const float sc = (u.pn == 0 || u.pn == 3) ? C2 : 1.f; const bool g = u.pn >= 9;
        if (u.pn == 4) {
#pragma unroll
            for (int bj = 0; bj < 2; ++bj) { float mx = 0.f;
#pragma unroll
                for (int ai = 0; ai < 2; ++ai)
#pragma unroll
                    for (int m = 0; m < 4; ++m) { float s = 0.f;
#pragma unroll
                        for (int n = 0; n < 2; ++n)
#pragma unroll
                            for (int e = 0; e < 4; ++e) s += acc[ai][bj][m][n][e] * acc[ai][bj][m][n][e];
                        { auto t = __builtin_amdgcn_permlane16_swap(__float_as_uint(s), __float_as_uint(s), false, false); s = __uint_as_float(t[0]) + __uint_as_float(t[1]); }
                        { auto t = __builtin_amdgcn_permlane32_swap(__float_as_uint(s), __float_as_uint(s), false, false); s = __uint_as_float(t[0]) + __uint_as_float(t[1]); }
                        mx = fmaxf(mx, s); }
                mx = wave_max(mx);
                if ((threadIdx.x & 63) == 0) atomicMax(kinf + ((u.pm >> 3) * 4 + 2 * bj + (wc >> 1)) * 2 + (wc & 1), __float_as_uint(mx)); } }
#pragma unroll
        for (int ai = 0; ai < 2; ++ai)
#pragma unroll
            for (int m = 0; m < 4; ++m) { bf16* rowp = O + (size_t)(row0 + ai * 128 + m * 16) * NPROJ + col0;
#pragma unroll
                for (int bj = 0; bj < 2; ++bj) { pg8::f32x4 v0 = acc[ai][bj][m][0], v1 = acc[ai][bj][m][1];
                    if (g) {
#pragma unroll
                        for (int e = 0; e < 4; ++e) { v0[e] = gelu_tanh_f(v0[e]); v1[e] = gelu_tanh_f(v1[e]); } }
                    v0 = v0 * sc; v1 = v1 * sc; v4u w; w.x = pg8::cvt_pk_bf16(v0[0], v0[1]); w.y = pg8::cvt_pk_bf16(v0[2], v0[3]); w.z = pg8::cvt_pk_bf16(v1[0], v1[1]); w.w = pg8::cvt_pk_bf16(v1[2], v1[3]);
                    MK_STORE16((v4u*)(rowp + bj * 128), w); } }
    }
};
struct EpiRes {
    static constexpr bool PERM = true, KSCALE = true; static constexpr int NSTORE = 16;
    bf16* X; const float* SS; LAS float* tab;
    __device__ __forceinline__ void kscale_begin(const pg8::Unit& u, int tid) const {
        if (tid < 256) { const f32x4 a = *(const f32x4*)(SS + (size_t)(u.pm * 256 + tid) * 8), b = *(const f32x4*)(SS + (size_t)(u.pm * 256 + tid) * 8 + 4);
            const float rA = rsqrtf(((a.x + a.y) + (a.z + a.w)) * (1.f / GW) + RMS_EPS), rB = rsqrtf(((b.x + b.y) + (b.z + b.w)) * (1.f / GW) + RMS_EPS);
            *(LAS f32x2*)(tab + 2 * tid) = (f32x2){rA / rB, rB}; }
    }
    __device__ __forceinline__ void kscale(pg8::f32x4 (&acc)[2][2][4][2], int which, int wr, int fr) const {
#pragma unroll
        for (int ai = 0; ai < 2; ++ai)
#pragma unroll
            for (int m = 0; m < 4; ++m) { const float s = tab[2 * (ai * 128 + wr * 64 + m * 16 + fr) + which];
#pragma unroll
                for (int bj = 0; bj < 2; ++bj)
#pragma unroll
                    for (int n = 0; n < 2; ++n) acc[ai][bj][m][n] = acc[ai][bj][m][n] * s; }
    }
    __device__ __forceinline__ void operator()(const pg8::f32x4 (&acc)[2][2][4][2], const pg8::Unit& u, int wr, int wc, int fr, int fq) const {
        const int row0 = u.pm * 256 + wr * 64 + fr, col0 = u.pn * 256 + wc * 32 + 8 * fq;
#pragma unroll
        for (int ai = 0; ai < 2; ++ai)
#pragma unroll
            for (int m = 0; m < 4; ++m) { bf16* rowp = X + (size_t)(row0 + ai * 128 + m * 16) * D + col0;
#pragma unroll
                for (int bj = 0; bj < 2; ++bj) { const pg8::f32x4 v0 = acc[ai][bj][m][0], v1 = acc[ai][bj][m][1]; v4u w;
                    w.x = pg8::cvt_pk_bf16(v0[0], v0[1]); w.y = pg8::cvt_pk_bf16(v0[2], v0[3]); w.z = pg8::cvt_pk_bf16(v1[0], v1[1]); w.w = pg8::cvt_pk_bf16(v1[2], v1[3]);
                    *(v4u*)(rowp + bj * 128) = w; } }
    }
};
struct EpiSwiglu {
    static constexpr bool PERM = true, KSCALE = false; static constexpr int NSTORE = 8;
    bf16* Hh;
    __device__ __forceinline__ void operator()(const pg8::f32x4 (&acc)[2][2][4][2], const pg8::Unit& u, int wr, int wc, int fr, int fq) const {
        const int row0 = u.pm * 256 + wr * 64 + fr, col0 = u.pn * 128 + wc * 32 + 8 * fq;
#pragma unroll
        for (int ai = 0; ai < 2; ++ai)
#pragma unroll
            for (int m = 0; m < 4; ++m) { float h[8];
#pragma unroll
                for (int n = 0; n < 2; ++n)
#pragma unroll
                    for (int e = 0; e < 4; ++e) { const float a1 = acc[ai][0][m][n][e], a3 = acc[ai][1][m][n][e];
                        h[n * 4 + e] = a1 * __builtin_amdgcn_rcpf(1.0f + __builtin_amdgcn_exp2f(-LOG2E * a1)) * a3; }
                v4u w; w.x = pg8::cvt_pk_bf16(h[0], h[1]); w.y = pg8::cvt_pk_bf16(h[2], h[3]); w.z = pg8::cvt_pk_bf16(h[4], h[5]); w.w = pg8::cvt_pk_bf16(h[6], h[7]);
                *(v4u*)(Hh + (size_t)(row0 + ai * 128 + m * 16) * DE + col0) = w; }
    }
};
struct EpiBf {
    static constexpr bool PERM = true, KSCALE = false; static constexpr int NSTORE = 16;
    bf16* O;
    __device__ __forceinline__ void operator()(const pg8::f32x4 (&acc)[2][2][4][2], const pg8::Unit& u, int wr, int wc, int fr, int fq) const {
        const int row0 = u.pm * 256 + wr * 64 + fr, col0 = u.pn * 256 + wc * 32 + 8 * fq;
#pragma unroll
        for (int ai = 0; ai < 2; ++ai)
#pragma unroll
            for (int m = 0; m < 4; ++m) { bf16* rowp = O + (size_t)(row0 + ai * 128 + m * 16) * D + col0;
#pragma unroll
                for (int bj = 0; bj < 2; ++bj) { const pg8::f32x4 v0 = acc[ai][bj][m][0], v1 = acc[ai][bj][m][1];
                    v4u w; w.x = pg8::cvt_pk_bf16(v0[0], v0[1]); w.y = pg8::cvt_pk_bf16(v0[2], v0[3]); w.z = pg8::cvt_pk_bf16(v1[0], v1[1]); w.w = pg8::cvt_pk_bf16(v1[2], v1[3]);
                    *(v4u*)(rowp + bj * 128) = w; } }
    }
};

struct EpiNone {
    static constexpr bool PERM = true, KSCALE = false; static constexpr int NSTORE = 8; float* sink;
    __device__ __forceinline__ void operator()(const pg8::f32x4 (&acc)[2][2][4][2], const pg8::Unit& u, int wr, int wc, int fr, int fq) const {
        float s = 0.f;
#pragma unroll
        for (int ai = 0; ai < 2; ++ai)
#pragma unroll
            for (int bj = 0; bj < 2; ++bj)
#pragma unroll
                for (int m = 0; m < 4; ++m)
#pragma unroll
                    for (int n = 0; n < 2; ++n) s += acc[ai][bj][m][n][0] + acc[ai][bj][m][n][3];
        if (s == 12345.678f) sink[0] = s;
    }
};

constexpr size_t MiB = 1u << 20;
constexpr size_t WS_CTL = 0, CTL_ZERO_BYTES = 1 * MiB;
constexpr size_t WS_LF = 1 * MiB;
constexpr size_t WS_SS = 2 * MiB;
constexpr size_t WS_TE = 3 * MiB;
constexpr size_t WS_TS = WS_TE + 256 * 1024, WS_TG = WS_TS + 256 * 1024;
constexpr size_t WS_RT = 4 * MiB;
constexpr size_t WS_RW = 12 * MiB;
constexpr size_t WS_SGW = 13 * MiB;
constexpr size_t WS_GL = 15 * MiB;
constexpr size_t WS_C2 = 14 * MiB;
constexpr size_t WS_WIN = 16 * MiB;
constexpr size_t WS_WOUT = 27 * MiB;
constexpr size_t WS_W13 = 31 * MiB;
constexpr size_t WS_W2 = 95 * MiB;
constexpr size_t WS_XN = 128 * MiB;
constexpr size_t WS_MIX = 192 * MiB;
constexpr size_t WS_PROJ = 256 * MiB;
constexpr size_t WS_H = 432 * MiB;
constexpr size_t WS_END = 468 * MiB;
constexpr int CW_BAR = 4096;
constexpr int CW_QUEUE = 8192;
constexpr int CW_KINF = 9216;
constexpr int CW_GATE = 9472;
constexpr int CW_CNT = 8448;
constexpr int RING_BYTES = 131072, LDSCTL_OFF = RING_BYTES, MISC_OFF = LDSCTL_OFF + 320, LDS_BYTES = 147456;

#define XB_TMO      128
#define XB_XCNT(j)  (256  + 64 * (j))
#define XB_XSUB(j)  (1280 + 64 * (j))
#define XB_XGEN(j)  (2304 + 64 * (j))
#define XB_TOP      3328
#define XB_TOPGEN   3392
#define XCD_BAR_WORDS 3456
#define XB_SPIN_CAP (1u << 18)
__device__ __forceinline__ unsigned xb_ld(unsigned* p)              { return __hip_atomic_load(p, __ATOMIC_RELAXED, __HIP_MEMORY_SCOPE_AGENT); }
__device__ __forceinline__ unsigned xb_add(unsigned* p, unsigned v) { return __hip_atomic_fetch_add(p, v, __ATOMIC_RELAXED, __HIP_MEMORY_SCOPE_AGENT); }
__device__ __forceinline__ unsigned xb_xcc_id() { return (unsigned)__builtin_amdgcn_s_getreg((3 << 11) | 20) & 0xFu; }
#define XB_SPIN(cond, bar) do { unsigned _sp = 0; while (cond) { __builtin_amdgcn_s_sleep(1); \
    if ((++_sp & 255u) == 0u) { if (xb_ld(&(bar)[XB_TMO])) break; if (_sp > XB_SPIN_CAP) { atomicAdd(&(bar)[XB_TMO], 1u); break; } } } } while (0)
struct XcdBarrier { unsigned* bar; unsigned x; volatile LAS unsigned* st; };
__device__ __forceinline__ XcdBarrier xcd_barrier_post(unsigned* bar, volatile LAS unsigned* st) {
    XcdBarrier b; b.bar = bar; b.x = xb_xcc_id(); b.st = st;
    if (threadIdx.x == 0) (void)xb_add(&bar[XB_XCNT(b.x)], 1u);
    return b;
}
__device__ __forceinline__ void xcd_barrier_complete(unsigned* bar, unsigned x, unsigned& nloc, unsigned& nx) {
    const unsigned G = gridDim.x * gridDim.y * gridDim.z;
    unsigned sum, cnt, mine, sp = 0u;
    for (;;) {
        sum = 0u; cnt = 0u; mine = 0u;
#pragma unroll
        for (unsigned j = 0; j < 16; ++j) { const unsigned c = xb_ld(&bar[XB_XCNT(j)]); sum += c; cnt += (c > 0u) ? 1u : 0u; mine = (j == x) ? c : mine; }
        if (sum == G) break;
        __builtin_amdgcn_s_sleep(1);
        if ((++sp & 255u) == 0u) { if (xb_ld(&bar[XB_TMO])) break; if (sp > XB_SPIN_CAP) { atomicAdd(&bar[XB_TMO], 1u); break; } }
    }
    nloc = mine > 0u ? mine : 1u; nx = cnt > 0u ? cnt : 1u;
}
__device__ __forceinline__ void xcd_barrier(const XcdBarrier& b) {
    asm volatile("s_waitcnt vmcnt(0)" ::: "memory");
    __syncthreads();
    if (threadIdx.x == 0) {
        unsigned* bar = b.bar;
        __builtin_amdgcn_s_waitcnt(0);
        unsigned nloc = b.st[0], nx = b.st[1];
        if (nloc == 0u) { xcd_barrier_complete(bar, b.x, nloc, nx); b.st[0] = nloc; b.st[1] = nx; }
        const unsigned old = xb_add(&bar[XB_XSUB(b.x)], 1u);
        const unsigned gen = old / nloc;
        if (old + 1u == (gen + 1u) * nloc) {
            __builtin_amdgcn_fence(__ATOMIC_RELEASE, "agent");
            asm volatile("s_waitcnt vmcnt(0)" ::: "memory");
            const unsigned og = xb_add(&bar[XB_TOP], 1u);
            const unsigned tg = og / nx;
            if (og + 1u == (tg + 1u) * nx) xb_add(&bar[XB_TOPGEN], 1u);
            else XB_SPIN(xb_ld(&bar[XB_TOPGEN]) == tg, bar);
            __builtin_amdgcn_fence(__ATOMIC_ACQUIRE, "agent");
            xb_add(&bar[XB_XGEN(b.x)], 1u);
            asm volatile("s_waitcnt vmcnt(0)" ::: "memory");
        } else {
            XB_SPIN(xb_ld(&bar[XB_XGEN(b.x)]) == gen, bar);
            __builtin_amdgcn_fence(__ATOMIC_ACQUIRE, "agent");
            asm volatile("s_waitcnt vmcnt(0)" ::: "memory");
        }
    }
    __syncthreads();
}

struct Args { const float* in[24]; float* out; unsigned char* ws; int ph_lo, ph_hi; };
struct Frame {
    LAS unsigned char* lds; unsigned char* lds_gen; volatile LAS unsigned* MISC; unsigned* ctl;
    int tid, lane, wave, G, vcu;
    unsigned char* ws; float* X;
};
__device__ __forceinline__ void p0_item(const float* W, int ldw, int c0, int k0, bf16* WT, int Kd, int drow, int drow2, const float* kscale, LAS float* scr, int lane) {
    const int nq = lane & 7, kr = lane >> 3; f32x4 v[2][8];
#pragma unroll
    for (int hf = 0; hf < 2; ++hf)
#pragma unroll
        for (int i = 0; i < 8; ++i) v[hf][i] = *(const f32x4*)(W + (size_t)(k0 + kr + 8 * i) * ldw + c0 + 32 * hf + 4 * nq);
    if (kscale) {
#pragma unroll
        for (int i = 0; i < 8; ++i) { const float sc = kscale[k0 + kr + 8 * i]; v[0][i] = v[0][i] * sc; v[1][i] = v[1][i] * sc; } }
    const int c = lane & 7;
#pragma unroll
    for (int hf = 0; hf < 2; ++hf) {
#pragma unroll
        for (int i = 0; i < 8; ++i)
#pragma unroll
            for (int e = 0; e < 4; ++e) scr[(kr + 8 * i) * 33 + 4 * nq + e] = v[hf][i][e];
        LDS_WAIT(); asm volatile("" ::: "memory");
        const int dr = hf ? drow2 : drow;
#pragma unroll
        for (int j = 0; j < 4; ++j) { const int n = (lane >> 3) + 8 * j; const LAS float* s = scr + (8 * c) * 33 + n;
            v4u o; o.x = pk2(s[0 * 33], s[1 * 33]); o.y = pk2(s[2 * 33], s[3 * 33]); o.z = pk2(s[4 * 33], s[5 * 33]); o.w = pk2(s[6 * 33], s[7 * 33]);
            *(v4u*)(WT + (size_t)(dr + n) * Kd + k0 + 8 * c) = o; }
        LDS_WAIT(); asm volatile("" ::: "memory");
    }
}
constexpr int PTAB_OFF = LDSCTL_OFF + 1024;
struct Ptrs {
    volatile LAS unsigned* tab; unsigned char* ws;
    __device__ __forceinline__ const float* in(int i) const { const unsigned lo = __builtin_amdgcn_readfirstlane(tab[2 * i]), hi = __builtin_amdgcn_readfirstlane(tab[2 * i + 1]); return (const float*)(const GAS float*)(((unsigned long long)hi << 32) | lo); }
    __device__ __forceinline__ const float* x() const { return in(0); }
    __device__ __forceinline__ const float* ln_in_g() const { return in(1); }
    __device__ __forceinline__ const float* ln_in_b() const { return in(2); }
    __device__ __forceinline__ const float* w_in() const { return in(3); }
    __device__ __forceinline__ const float* b_f() const { return in(4); }
    __device__ __forceinline__ const float* conv_w() const { return in(5); }
    __device__ __forceinline__ const float* conv_b() const { return in(6); }
    __device__ __forceinline__ const float* sgu_ln_g() const { return in(7); }
    __device__ __forceinline__ const float* sgu_ln_b() const { return in(8); }
    __device__ __forceinline__ const float* sgu_w() const { return in(9); }
    __device__ __forceinline__ const float* sgu_b() const { return in(10); }
    __device__ __forceinline__ const float* grp_g() const { return in(11); }
    __device__ __forceinline__ const float* w_out() const { return in(12); }
    __device__ __forceinline__ const float* ln1_g() const { return in(13); }
    __device__ __forceinline__ const float* ln1_b() const { return in(14); }
    __device__ __forceinline__ const float* rgw() const { return in(15); }
    __device__ __forceinline__ const float* rgb() const { return in(16); }
    __device__ __forceinline__ const float* rew() const { return in(17); }
    __device__ __forceinline__ const float* reb() const { return in(18); }
    __device__ __forceinline__ const float* w1() const { return in(19); }
    __device__ __forceinline__ const float* w3() const { return in(20); }
    __device__ __forceinline__ const float* w2() const { return in(21); }
    __device__ __forceinline__ const float* ln2_g() const { return in(22); }
    __device__ __forceinline__ const float* ln2_b() const { return in(23); }
    __device__ __forceinline__ float* LF() const { return (float*)(ws + WS_LF); }
    __device__ __forceinline__ float* C2G() const { return (float*)(ws + WS_C2); }
    __device__ __forceinline__ float* GL() const { return (float*)(ws + WS_GL); }
    __device__ __forceinline__ float* SS() const { return (float*)(ws + WS_SS); }
    __device__ __forceinline__ float* TG() const { return (float*)(ws + WS_TG); }
    __device__ __forceinline__ int* TE() const { return (int*)(ws + WS_TE); }
    __device__ __forceinline__ int* TS() const { return (int*)(ws + WS_TS); }
    __device__ __forceinline__ int* RT() const { return (int*)(ws + WS_RT); }
    __device__ __forceinline__ bf16* RW() const { return (bf16*)(ws + WS_RW); }
    __device__ __forceinline__ bf16* SGW() const { return (bf16*)(ws + WS_SGW); }
    __device__ __forceinline__ bf16* WIN() const { return (bf16*)(ws + WS_WIN); }
    __device__ __forceinline__ bf16* WOUT() const { return (bf16*)(ws + WS_WOUT); }
    __device__ __forceinline__ bf16* W13() const { return (bf16*)(ws + WS_W13); }
    __device__ __forceinline__ bf16* W2() const { return (bf16*)(ws + WS_W2); }
    __device__ __forceinline__ bf16* XN() const { return (bf16*)(ws + WS_XN); }
    __device__ __forceinline__ bf16* MIX() const { return (bf16*)(ws + WS_MIX); }
    __device__ __forceinline__ bf16* PROJ() const { return (bf16*)(ws + WS_PROJ); }
    __device__ __forceinline__ bf16* MOUT() const { return (bf16*)(ws + WS_PROJ); }
    __device__ __forceinline__ bf16* O() const { return (bf16*)(ws + WS_PROJ); }
    __device__ __forceinline__ bf16* H() const { return (bf16*)(ws + WS_H); }
};
__device__ __forceinline__ void p0_weights(Frame& F, const Ptrs& P) {
    LAS float* scr = (LAS float*)(F.lds + F.wave * 16384);
    const int gw = F.vcu * 8 + F.wave, NGW = F.G * 8;
    constexpr int I_IN = 16 * 44, I_OUT = 16 * 16, PER_L = I_IN + I_OUT;
    for (int it = gw; it < NL * PER_L; it += NGW) {
        const int l = it / PER_L; int r = it % PER_L;
        if (r < I_IN) { const int kb = r / 44, nb = r % 44, n0 = 64 * nb; p0_item(P.w_in() + (size_t)l * D * PWIN, PWIN, n0 + (n0 >= 1536 ? 4 : 0), 64 * kb, P.WIN() + (size_t)l * NPROJ * D, D, n0, n0 + 32, nullptr, scr, F.lane); continue; } r -= I_IN;
        { const int kb = r / 16, nb = r % 16; p0_item(P.w_out() + (size_t)l * D * D, D, 64 * nb, 64 * kb, P.WOUT() + (size_t)l * D * D, D, 64 * nb, 64 * nb + 32, P.grp_g() + l * D, scr, F.lane); }
    }
    const int gt = F.vcu * 512 + F.tid, NGT = F.G * 512;
    for (int i = gt; i < NL * 64 * D; i += NGT) { const int l = i / (64 * D), row = (i / D) % 64, k = i % D;
        float v = 0.f; if (row < 32) v = P.rew()[((size_t)l * D + k) * 32 + row]; else if (row < 36) v = P.rgw()[((size_t)l * D + k) * 4 + (row - 32)];
        const unsigned hi = f2bf(v); const float lo = v - bf2f(hi);
        P.RW()[((size_t)(l * 2 + 0) * 64 + row) * D + k] = (bf16)hi; P.RW()[((size_t)(l * 2 + 1) * 64 + row) * D + k] = (bf16)f2bf(lo); }
    for (int i = gt; i < NL * NH * 128 * 128; i += NGT) { const int ii = (i >> 7) & 127, j = i & 127; const float v = ((j >> 6) <= (ii >> 6)) ? P.sgu_w()[i] : 0.f; P.SGW()[i] = (bf16)f2bf(v); }
}

struct WfRegs { f32x4 w[4][4]; };
__device__ __forceinline__ void load_wf(WfRegs& R, const float* w_in_l, int lane, int ld = PWIN, int col = 1536) {
#pragma unroll
    for (int j = 0; j < 4; ++j)
#pragma unroll
        for (int i = 0; i < 4; ++i) R.w[j][i] = *(const f32x4*)(w_in_l + (size_t)(4 * lane + 256 * j + i) * ld + col);
}
__device__ __forceinline__ void load_gb(f32x4 (&gr)[4], f32x4 (&br)[4], const float* g, const float* b, int lane) {
#pragma unroll
    for (int j = 0; j < 4; ++j) { gr[j] = *(const f32x4*)(g + 4 * lane + 256 * j); br[j] = *(const f32x4*)(b + 4 * lane + 256 * j); }
}
template <int LFL, bool WF32, bool WBF = true>
__device__ __forceinline__ void finish_row(f32x4 (&v)[4], const f32x4 (&gr)[4], const f32x4 (&br)[4], float* xrow, bf16* xnrow, const WfRegs& R, const f32x4 bf, float* lfrow, int lane) {
    float s = 0.f;
#pragma unroll
    for (int j = 0; j < 4; ++j) s += (v[j].x + v[j].y) + (v[j].z + v[j].w);
    const float mean = wave_sum(s) * (1.f / D); float s2 = 0.f;
#pragma unroll
    for (int j = 0; j < 4; ++j) { v[j] = v[j] - mean; s2 += (v[j].x * v[j].x + v[j].y * v[j].y) + (v[j].z * v[j].z + v[j].w * v[j].w); }
    const float rstd = rsqrtf(wave_sum(s2) * (1.f / D) + LN_EPS);
    f32x4 dots = {0.f, 0.f, 0.f, 0.f};
#pragma unroll
    for (int j = 0; j < 4; ++j) {
        const f32x4 y = v[j] * rstd * gr[j] + br[j];
        if (WF32) *(f32x4*)(xrow + 4 * lane + 256 * j) = y;
        if (WBF) { v2u o; o.x = pk2(y.x, y.y); o.y = pk2(y.z, y.w); *(v2u*)(xnrow + 4 * lane + 256 * j) = o; }
        if (LFL) dots = dots + R.w[j][0] * y.x + R.w[j][1] * y.y + R.w[j][2] * y.z + R.w[j][3] * y.w; }
    if (LFL) {
        const float d0 = wave_sum(dots.x), d1 = wave_sum(dots.y), d2 = wave_sum(dots.z), d3 = wave_sum(dots.w);
        if (lane == 0) { f32x4 o; if (LFL == 1) { o.x = log_sigmoid_f(d0 + bf[0]); o.y = log_sigmoid_f(d1 + bf[1]); o.z = log_sigmoid_f(d2 + bf[2]); o.w = log_sigmoid_f(d3 + bf[3]); } else { o.x = d0 + bf[0]; o.y = d1 + bf[1]; o.z = d2 + bf[2]; o.w = d3 + bf[3]; } *(f32x4*)lfrow = o; }
    }
}
__device__ __forceinline__ void p0_rows(Frame& F, const Ptrs& P) {
    WfRegs R; load_wf(R, P.w_in(), F.lane);
    const int gw = F.vcu * 8 + F.wave, NGW = F.G * 8;
    const float* x = P.x(); const f32x4 bf = *(const f32x4*)P.b_f(); bf16* XN = P.XN(); float* LF = P.LF();
    f32x4 lg[4], lb[4]; load_gb(lg, lb, P.ln_in_g(), P.ln_in_b(), F.lane);
    f32x4 cur[4], nxt[4];
    if (gw < T) {
#pragma unroll
        for (int j = 0; j < 4; ++j) cur[j] = *(const f32x4*)(x + (size_t)gw * D + 4 * F.lane + 256 * j); }
    for (int m = gw; m < T; m += NGW) {
        const int mn = m + NGW;
        if (mn < T) {
#pragma unroll
            for (int j = 0; j < 4; ++j) nxt[j] = *(const f32x4*)(x + (size_t)mn * D + 4 * F.lane + 256 * j); }
        finish_row<1, false>(cur, lg, lb, nullptr, XN + (size_t)m * D, R, bf, LF + (size_t)m * 4, F.lane);
#pragma unroll
        for (int j = 0; j < 4; ++j) cur[j] = nxt[j];
    }
}
__device__ __forceinline__ void c2_scan(Frame& F, const Ptrs& P, int bh) {
    const int tid = F.tid, lane = F.lane, w = F.wave; LAS float* red = (LAS float*)(F.lds);
    const size_t row0 = (size_t)(bh >> 2) * S; const int h = bh & 3;
    float a[4];
#pragma unroll
    for (int i = 0; i < 4; ++i) a[i] = P.LF()[(row0 + 4 * tid + i) * 4 + h] * LOG2E;
    a[1] += a[0]; a[2] += a[1]; a[3] += a[2];
    float run = a[3];
#pragma unroll
    for (int o = 1; o < 64; o <<= 1) { const float t = __shfl_up(run, o); if (lane >= o) run += t; }
    if (lane == 63) red[w] = run;
    __syncthreads();
    float base = run - a[3];
    for (int i = 0; i < w; ++i) base += red[i];
    f32x4 o; o.x = base + a[0]; o.y = base + a[1]; o.z = base + a[2]; o.w = base + a[3];
    *(f32x4*)(P.C2G() + (size_t)bh * S + 4 * tid) = o;
    __syncthreads();
}

typedef short v4i16_t __attribute__((ext_vector_type(4)));
__device__ __forceinline__ s16x4 vtr(const LAS unsigned char* p) { return __builtin_bit_cast(s16x4, __builtin_amdgcn_ds_read_tr16_b64_v4i16((LAS v4i16_t*)p)); }
__device__ __forceinline__ int crow(int r, int hi) { return (r & 3) + 8 * (r >> 2) + 4 * hi; }
__device__ __forceinline__ bf16x8 pack8(const f32x16& p, int b0) {
    v4u w; w.x = pk2(p[b0], p[b0 + 1]); w.y = pk2(p[b0 + 2], p[b0 + 3]); w.z = pk2(p[b0 + 4], p[b0 + 5]); w.w = pk2(p[b0 + 6], p[b0 + 7]); return __builtin_bit_cast(bf16x8, w);
}
constexpr int AT_K = 0, AT_V = 16384, AT_C = 32768, AT_RED = 40960;

template <bool STICK, bool DIAG, int MODE = 0>
__device__ __forceinline__ void attn_tile(const LAS unsigned char* Kb, const LAS unsigned char* Vb, const int (&kra)[4], const int vp0, const bf16x8 (&qr)[4],
                                          const LAS float* CBt, f32x16& cbase, const int qrel_, const int hh, f32x16 (&o)[2], float& m_run, float& l_run, float& Rp) {
    if (MODE == 3) return;
    int qrel = qrel_; if (DIAG) asm volatile("" : "+v"(qrel));
    bf16x8 kf[2][4];
#pragma unroll
    for (int kb = 0; kb < 2; ++kb)
#pragma unroll
        for (int ks = 0; ks < 4; ++ks) kf[kb][ks] = (MODE == 4) ? qr[(ks + kb) & 3] : *(const LAS bf16x8*)(Kb + kra[ks] + kb * 4096);
    f32x16 sc[2];
#pragma unroll
    for (int kb = 0; kb < 2; ++kb) { f32x16 a = STICK ? f32x16{} : cbase;
#pragma unroll
        for (int ks = 0; ks < 4; ++ks) a = __builtin_amdgcn_mfma_f32_32x32x16_bf16(kf[kb][ks], qr[ks], a, 0, 0, 0);
        sc[kb] = a; }
    s16x4 vlo[4], vhi[4];
#pragma unroll
    for (int ks = 0; ks < 4; ++ks) { if (MODE == 5) { vlo[ks] = __builtin_bit_cast(s16x4, (v2u){(unsigned)qr[ks][0], (unsigned)qr[ks][1]}); vhi[ks] = vlo[ks]; } else { vlo[ks] = vtr(Vb + vp0 + ks * 1024); vhi[ks] = vtr(Vb + vp0 + ks * 1024 + 512); } }
    if (MODE == 1) {
#pragma unroll
        for (int i = 0; i < 16; ++i) { sc[0][i] *= 0.001f; sc[1][i] *= 0.001f; }
    } else if (!STICK) {
#pragma unroll
        for (int kb = 0; kb < 2; ++kb)
#pragma unroll
            for (int g4 = 0; g4 < 4; ++g4) { const f32x4 ncs = *(const LAS f32x4*)(CBt + 32 * kb + 8 * g4 + 4 * hh);
                f32x2 a = {sc[kb][4 * g4], sc[kb][4 * g4 + 1]}, c = {sc[kb][4 * g4 + 2], sc[kb][4 * g4 + 3]};
                a = a + (f32x2){ncs.x, ncs.y}; c = c + (f32x2){ncs.z, ncs.w};
                sc[kb][4 * g4] = a.x; sc[kb][4 * g4 + 1] = a.y; sc[kb][4 * g4 + 2] = c.x; sc[kb][4 * g4 + 3] = c.y;
                if (DIAG) {
#pragma unroll
                    for (int e = 0; e < 4; ++e) sc[kb][4 * g4 + e] = (32 * kb + 8 * g4 + 4 * hh + e > qrel) ? -1e30f : sc[kb][4 * g4 + e]; } }
        float m0 = fmaxf(fmaxf(sc[0][0], sc[0][1]), sc[0][2]), m1 = fmaxf(fmaxf(sc[1][0], sc[1][1]), sc[1][2]);
#pragma unroll
        for (int i = 3; i < 15; i += 2) { m0 = fmaxf(fmaxf(m0, sc[0][i]), sc[0][i + 1]); m1 = fmaxf(fmaxf(m1, sc[1][i]), sc[1][i + 1]); }
        float mx = fmaxf(fmaxf(m0, m1), fmaxf(sc[0][15], sc[1][15]));
        mx = fmaxf(mx, other_half(mx));
        if (__any(mx > 0.f)) {
            const float dl = fmaxf(mx, 0.f), alpha = __builtin_amdgcn_exp2f(-dl); m_run += dl; l_run *= alpha;
#pragma unroll
            for (int i = 0; i < 16; ++i) { o[0][i] *= alpha; o[1][i] *= alpha; sc[0][i] -= dl; sc[1][i] -= dl; cbase[i] -= dl; }
        }
        f32x2 ps2 = {0.f, 0.f};
#pragma unroll
        for (int kb = 0; kb < 2; ++kb)
#pragma unroll
            for (int i = 0; i < 16; i += 2) { f32x2 p = {__builtin_amdgcn_exp2f(sc[kb][i]), __builtin_amdgcn_exp2f(sc[kb][i + 1])}; sc[kb][i] = p.x; sc[kb][i + 1] = p.y; ps2 = ps2 + p; }
        l_run += ps2.x + ps2.y;
    } else {
#pragma unroll
        for (int kb = 1; kb >= 0; --kb) {
            float om[16], be[16];
#pragma unroll
            for (int i = 0; i < 16; ++i) { const float e = __builtin_amdgcn_exp2f(sc[kb][i]); float t = __builtin_amdgcn_rcpf(1.0f + e);
                if (DIAG) t = (32 * kb + crow(i, 0) + 4 * hh >= qrel) ? 1.0f : t;
                om[i] = t; be[i] = 1.0f - t; }
            float se[16], gp[4], pr[4], og[4];
#pragma unroll
            for (int g4 = 0; g4 < 4; ++g4) { se[4 * g4 + 3] = 1.0f; se[4 * g4 + 2] = om[4 * g4 + 3]; se[4 * g4 + 1] = se[4 * g4 + 2] * om[4 * g4 + 2]; se[4 * g4] = se[4 * g4 + 1] * om[4 * g4 + 1]; gp[g4] = se[4 * g4] * om[4 * g4];
                og[g4] = other_half(gp[g4]); pr[g4] = gp[g4] * og[g4]; }
            float later = Rp;
#pragma unroll
            for (int g4 = 3; g4 >= 0; --g4) { const float fac = later * (hh ? 1.0f : og[g4]);
#pragma unroll
                for (int e = 0; e < 4; ++e) sc[kb][4 * g4 + e] = be[4 * g4 + e] * se[4 * g4 + e] * fac;
                later *= pr[g4]; }
            Rp = later;
        }
    }
    bf16x8 pf[4]; pf[0] = pack8(sc[0], 0); pf[1] = pack8(sc[0], 8); pf[2] = pack8(sc[1], 0); pf[3] = pack8(sc[1], 8);
    if (MODE == 2) { o[0][0] += __builtin_bit_cast(v4u, pf[0]).x + __builtin_bit_cast(v4u, pf[1]).x + __builtin_bit_cast(v4u, pf[2]).x + __builtin_bit_cast(v4u, pf[3]).x + vlo[0][0] + vhi[3][0]; return; }
    s16x4 wlo[4], whi[4];
#pragma unroll
    for (int ks = 0; ks < 4; ++ks) { if (MODE == 5) { wlo[ks] = vlo[ks]; whi[ks] = vhi[ks]; } else { wlo[ks] = vtr(Vb + vp0 + 4096 + ks * 1024); whi[ks] = vtr(Vb + vp0 + 4096 + ks * 1024 + 512); } }
#pragma unroll
    for (int ks = 0; ks < 4; ++ks) { const bf16x8 vf = (bf16x8){vlo[ks][0], vlo[ks][1], vlo[ks][2], vlo[ks][3], vhi[ks][0], vhi[ks][1], vhi[ks][2], vhi[ks][3]};
        o[0] = __builtin_amdgcn_mfma_f32_32x32x16_bf16(vf, pf[ks], o[0], 0, 0, 0); }
#pragma unroll
    for (int ks = 0; ks < 4; ++ks) { const bf16x8 vf = (bf16x8){wlo[ks][0], wlo[ks][1], wlo[ks][2], wlo[ks][3], whi[ks][0], whi[ks][1], whi[ks][2], whi[ks][3]};
        o[1] = __builtin_amdgcn_mfma_f32_32x32x16_bf16(vf, pf[ks], o[1], 0, 0, 0); }
}

constexpr int AT_CB = LDSCTL_OFF + 4096;
template <bool STICK, int MODE = 0>
__device__ __forceinline__ void attn_unit(Frame& F, const Ptrs& P, int layer, int b, int h, int qb) {
    const int tid = F.tid, lane = F.lane, w = F.wave, r = lane & 31, hh = lane >> 5;
    const int qcol = (STICK ? 0 : 768) + h * HD, kcol = qcol + 256, vcol = qcol + 512, ocol = (STICK ? 0 : 256) + h * HD;
    const size_t row0 = (size_t)b * S;
    LAS unsigned char* lds = F.lds;
    const int skrow = 8 * w + (lane >> 3);
    const bf16* ksrc = P.PROJ() + (row0 + skrow) * NPROJ + kcol + 8 * ((lane & 7) ^ ((skrow >> 1) & 7));
    const bf16* vsrc = P.PROJ() + (row0 + 16 * (w & 3) + (lane >> 2)) * NPROJ + vcol + 32 * ((w >> 2) & 1) + 8 * (lane & 3);
#define ATT_STAGE(c_, bsel_) do { const size_t co_ = (size_t)(c_) * 256 * NPROJ; _Pragma("unroll") for (int j_ = 0; j_ < 4; ++j_) { \
        __builtin_amdgcn_global_load_lds((const unsigned*)(ksrc + co_ + (size_t)j_ * 64 * NPROJ), (LAS unsigned*)(lds + (bsel_) * 65536 + (64 * j_ + 8 * w) * 128), 16, 0, 0); \
        __builtin_amdgcn_global_load_lds((const unsigned*)(vsrc + co_ + (size_t)j_ * 64 * NPROJ), (LAS unsigned*)(lds + (bsel_) * 65536 + 32768 + (8 * j_ + w) * 1024), 16, 0, 0); } } while (0)
    ATT_STAGE(qb, 0);
    __builtin_amdgcn_sched_barrier(0);
    LAS float* CB = (LAS float*)(lds + AT_CB);
    if (!STICK) { if (tid < 64 * (qb + 1)) *(LAS f32x4*)(CB + 4 * tid) = -*(const f32x4*)(P.C2G() + (size_t)(b * NH + h) * S + 4 * tid); }
    const int qrow = 256 * qb + 32 * w + r;
    bf16x8 qr[4];
#pragma unroll
    for (int ks = 0; ks < 4; ++ks) qr[ks] = *(const bf16x8*)(P.PROJ() + (row0 + qrow) * NPROJ + qcol + 16 * ks + 8 * hh);
    const int my_hi = 4 * qb + (w >> 1), qrel = 32 * (w & 1) + r;
    float zb = 0.f;
    if (!STICK) { float s2 = 0.f;
#pragma unroll
        for (int ks = 0; ks < 4; ++ks) { const v4u qq = __builtin_bit_cast(v4u, qr[ks]);
            s2 += (bflo(qq.x) * bflo(qq.x) + bfhi(qq.x) * bfhi(qq.x)) + (bflo(qq.y) * bflo(qq.y) + bfhi(qq.y) * bfhi(qq.y)) + (bflo(qq.z) * bflo(qq.z) + bfhi(qq.z) * bfhi(qq.z)) + (bflo(qq.w) * bflo(qq.w) + bfhi(qq.w) * bfhi(qq.w)); }
        s2 += other_half(s2);
        const unsigned* kw = F.ctl + CW_KINF + 128 * layer + (b * 4 + h) * 2;
        const float k2 = __uint_as_float(__hip_atomic_load(kw, RLX_AGENT)) + __uint_as_float(__hip_atomic_load(kw + 1, RLX_AGENT));
        zb = sqrtf(s2 * k2) * 1.01f; }
    const int vp0 = ((lane >> 4) & 1) * 32 + (lane & 3) * 8 + (4 * hh + ((lane & 15) >> 2)) * 64;
    int kra[4];
#pragma unroll
    for (int ks = 0; ks < 4; ++ks) kra[ks] = r * 128 + (((2 * ks + hh) ^ ((r >> 1) & 7)) * 16);
    f32x16 o[2]; o[0] = f32x16{}; o[1] = f32x16{};
    float m_run = 0.f, l_run = 0.f, Rp = 1.0f, ct2 = 0.f;
    asm volatile("s_waitcnt vmcnt(0)" ::: "memory");
    __syncthreads();
    if (!STICK) ct2 = -CB[qrow];
    f32x16 cbase;
#pragma unroll
    for (int i = 0; i < 16; ++i) cbase[i] = ct2;
    int buf = 0; bool wdone = false;
    for (int c = qb; c >= 0; --c) {
        if (c > 0) ATT_STAGE(c - 1, buf ^ 1);
#pragma nounroll
        for (int t4 = 3; t4 >= 0; --t4) { const int kt = 4 * c + t4;
            if (kt <= my_hi && !wdone) { const LAS unsigned char* Kb = lds + buf * 65536 + t4 * 8192; const LAS unsigned char* Vb = Kb + 32768;
                if (kt == my_hi) attn_tile<STICK, true, MODE>(Kb, Vb, kra, vp0, qr, CB + 64 * kt, cbase, qrel, hh, o, m_run, l_run, Rp);
                else attn_tile<STICK, false, MODE>(Kb, Vb, kra, vp0, qr, CB + 64 * kt, cbase, qrel, hh, o, m_run, l_run, Rp);
                wdone = STICK ? __all(Rp < 1e-14f) : (kt > 0 && __all(zb + ct2 + CB[64 * kt - 1] - m_run < -48.f)); } }
        if (lane == 0) F.MISC[16 + 8 * (c & 1) + w] = wdone ? 1u : 0u;
        asm volatile("s_waitcnt vmcnt(0)" ::: "memory");
        __syncthreads();
        buf ^= 1;
        unsigned all_ = 1u;
#pragma unroll
        for (int i_ = 0; i_ < 8; ++i_) all_ &= F.MISC[16 + 8 * (c & 1) + i_];
        if (all_) break;
    }
#undef ATT_STAGE
    float inv = 1.0f;
    if (!STICK) { const float lt = l_run + other_half(l_run); inv = 1.0f / lt; }
    float ss = 0.f;
#pragma unroll
    for (int dh = 0; dh < 2; ++dh)
#pragma unroll
        for (int i = 0; i < 16; ++i) { o[dh][i] *= inv; ss += o[dh][i] * o[dh][i]; }
    ss += other_half(ss);
    const size_t tok = row0 + qrow;
    if (hh == 0) P.SS()[tok * 8 + (STICK ? 0 : 4) + h] = ss;
    LAS unsigned char* stg = lds + w * 4608;
#pragma unroll
    for (int dh = 0; dh < 2; ++dh)
#pragma unroll
        for (int g4 = 0; g4 < 4; ++g4) { v2u ov; ov.x = pk2(o[dh][4 * g4], o[dh][4 * g4 + 1]); ov.y = pk2(o[dh][4 * g4 + 2], o[dh][4 * g4 + 3]); *(LAS v2u*)(stg + r * 144 + (32 * dh + 8 * g4 + 4 * hh) * 2) = ov; }
    LDS_WAIT();
    bf16* ob = P.MIX() + (row0 + 256 * qb + 32 * w) * D + ocol;
#pragma unroll
    for (int i = 0; i < 4; ++i) { const int row = 8 * i + (lane >> 3), ch = lane & 7; const v4u v = *(const LAS v4u*)(stg + row * 144 + ch * 16); *(v4u*)(ob + (size_t)row * D + 8 * ch) = v; }
}

__device__ __forceinline__ f32x4 ld4bf(const bf16* p) { const v2u q = *(const v2u*)p; return (f32x4){bflo(q.x), bfhi(q.x), bflo(q.y), bfhi(q.y)}; }
#define UNP(q) ((f32x4){bflo((q).x), bfhi((q).x), bflo((q).y), bfhi((q).y)})
__device__ __forceinline__ void conv_unit(Frame& F, const Ptrs& P, int layer, int cu) {
    const int lane = F.lane, c = 4 * lane;
    const float* cw = P.conv_w() + (size_t)layer * 3 * GW; const f32x4 w0 = *(const f32x4*)(cw + c), w1 = *(const f32x4*)(cw + GW + c), w2 = *(const f32x4*)(cw + 2 * GW + c), cb = *(const f32x4*)(P.conv_b() + (size_t)layer * GW + c);
    const int tok0 = cu * 128 + F.wave * 16, t0 = tok0 % S;
    const char* ub = (const char*)(P.PROJ() + (size_t)tok0 * NPROJ); char* mb = (char*)(P.MIX() + (size_t)tok0 * D + 512); const unsigned lo = 8u * (unsigned)lane;
#define CLD(i, col) (*(const v2u*)(ub + (ptrdiff_t)(i) * (NPROJ * 2) + (col) * 2 + lo))
    f32x4 z2 = {0.f, 0.f, 0.f, 0.f}, z1 = {0.f, 0.f, 0.f, 0.f};
    if (t0 >= 2) { z2 = UNP(CLD(-2, 1536)) * UNP(CLD(-2, 2048)); z1 = UNP(CLD(-1, 1536)) * UNP(CLD(-1, 2048)); }
#pragma unroll
    for (int hf = 0; hf < 2; ++hf) {
        v2u hq[8], cq[8], bq[8];
#pragma unroll
        for (int i = 0; i < 8; ++i) { hq[i] = CLD(8 * hf + i, 1536); cq[i] = CLD(8 * hf + i, 2048); bq[i] = CLD(8 * hf + i, 1792); }
#pragma unroll
        for (int i = 0; i < 8; ++i) {
            const f32x4 z0 = UNP(hq[i]) * UNP(cq[i]), bg = UNP(bq[i]);
            const f32x4 y = bg * (cb + w0 * z2 + w1 * z1 + w2 * z0);
            const float q = wave_sum((y.x * y.x + y.y * y.y) + (y.z * y.z + y.w * y.w));
            const float rs = rsqrtf(q * (1.f / GW) + RMS_EPS);
            v2u o; o.x = pk2(y.x * rs, y.y * rs); o.y = pk2(y.z * rs, y.w * rs); *(v2u*)(mb + (size_t)(8 * hf + i) * (D * 2) + lo) = o;
            z2 = z1; z1 = z0; }
    }
#undef CLD
}

constexpr int SG_VL = 0, SG_SSQ = 65536;
template <int MODE = 0>
__device__ __forceinline__ void sgu_unit(Frame& F, const Ptrs& P, int layer, int su) {
    const int lane = F.lane, w = F.wave, r = lane & 31, hh = lane >> 5;
    const size_t base = (size_t)su * 128;
    LAS unsigned char* lds = F.lds;
    const int g = w >> 1, ih = w & 1;
    const bf16* wg0 = P.SGW() + ((size_t)(layer * NH + g) * 128 + 64 * ih + r) * 128 + 4 * hh; const bf16* wg1 = wg0 + 32 * 128;
    asm volatile("" : "+v"(wg0), "+v"(wg1));
    v2u wq[8][2][2];
    {
        const int c = 4 * lane; const f32x4 gg = *(const f32x4*)(P.sgu_ln_g() + (size_t)layer * GW + c), bb = *(const f32x4*)(P.sgu_ln_b() + (size_t)layer * GW + c);
        const bf16* vp = P.PROJ() + (base + 16 * w) * NPROJ + 2560 + c; v2u vq[16];
#pragma unroll
        for (int i = 0; i < 16; ++i) vq[i] = *(const v2u*)(vp + (size_t)i * NPROJ);
#pragma unroll
    for (int ks = 0; ks < 8; ++ks) { wq[ks][0][0] = *(const v2u*)(wg0 + 16 * ks); wq[ks][0][1] = *(const v2u*)(wg0 + 16 * ks + 8); wq[ks][1][0] = *(const v2u*)(wg1 + 16 * ks); wq[ks][1][1] = *(const v2u*)(wg1 + 16 * ks + 8); }
    __builtin_amdgcn_sched_barrier(0);
#pragma unroll
        for (int i = 0; i < 16; ++i) { const int j = 16 * w + i; f32x4 v = UNP(vq[i]);
            if (MODE == 12) { v2u o; o.x = pk2(v.x, v.y); o.y = pk2(v.z, v.w); *(LAS v2u*)(lds + SG_VL + (c >> 5) * 8192 + (j >> 4) * 1024 + (j & 15) * 64 + (c & 31) * 2) = o; continue; }
            const float mean = wave_sum((v.x + v.y) + (v.z + v.w)) * (1.f / GW); v = v - mean;
            const float rstd = rsqrtf(wave_sum((v.x * v.x + v.y * v.y) + (v.z * v.z + v.w * v.w)) * (1.f / GW) + LN_EPS);
            v = v * rstd * gg + bb; v2u o; o.x = pk2(v.x, v.y); o.y = pk2(v.z, v.w);
            *(LAS v2u*)(lds + SG_VL + (c >> 5) * 8192 + (j >> 4) * 1024 + (j & 15) * 64 + (c & 31) * 2) = o; }
    }
    __syncthreads();
    f32x16 acc[2][2]; acc[0][0] = f32x16{}; acc[0][1] = f32x16{}; acc[1][0] = f32x16{}; acc[1][1] = f32x16{};
    const int vp0 = ((lane >> 4) & 1) * 32 + (lane & 3) * 8 + (4 * hh + ((lane & 15) >> 2)) * 64;
    v2u uq[2][2][4];
#pragma unroll
    for (int ib = 0; ib < 2; ++ib)
#pragma unroll
        for (int cb = 0; cb < 2; ++cb)
#pragma unroll
            for (int g4 = 0; g4 < 4; ++g4) uq[ib][cb][g4] = *(const v2u*)(P.PROJ() + (base + 64 * ih + 32 * ib + r) * NPROJ + 2304 + 64 * g + 32 * cb + 8 * g4 + 4 * hh);
    __builtin_amdgcn_sched_barrier(0);
#pragma unroll
    for (int ks = 0; ks < (MODE == 11 ? 0 : 8); ++ks) {
        bf16x8 wf[2], vf[2];
#pragma unroll
        for (int ib = 0; ib < 2; ++ib) { v4u t; t.x = wq[ks][ib][0].x; t.y = wq[ks][ib][0].y; t.z = wq[ks][ib][1].x; t.w = wq[ks][ib][1].y; wf[ib] = __builtin_bit_cast(bf16x8, t); }
#pragma unroll
        for (int cb = 0; cb < 2; ++cb) { const LAS unsigned char* vb = lds + SG_VL + (2 * g + cb) * 8192 + ks * 1024 + vp0; const s16x4 lo = vtr(vb), hi = vtr(vb + 512);
            vf[cb] = (bf16x8){lo[0], lo[1], lo[2], lo[3], hi[0], hi[1], hi[2], hi[3]}; }
#pragma unroll
        for (int cb = 0; cb < 2; ++cb)
#pragma unroll
            for (int ib = 0; ib < 2; ++ib) acc[cb][ib] = __builtin_amdgcn_mfma_f32_32x32x16_bf16(vf[cb], wf[ib], acc[cb][ib], 0, 0, 0);
    }
    LAS float* SSQ = (LAS float*)(lds + SG_SSQ);
#pragma unroll
    for (int ib = 0; ib < 2; ++ib) { const int i = 64 * ih + 32 * ib + r; const float bs = P.sgu_b()[(size_t)(layer * NH + g) * 128 + i]; float q = 0.f;
#pragma unroll
        for (int cb = 0; cb < 2; ++cb)
#pragma unroll
            for (int g4 = 0; g4 < 4; ++g4) { const f32x4 uu = UNP(uq[ib][cb][g4]);
#pragma unroll
                for (int e = 0; e < 4; ++e) { const float t = uu[e] * (acc[cb][ib][4 * g4 + e] + bs); acc[cb][ib][4 * g4 + e] = t; q += t * t; } }
        q += other_half(q);
        if (hh == 0) SSQ[i * 4 + g] = q; }
    __syncthreads();
#pragma unroll
    for (int ib = 0; ib < 2; ++ib) { const int i = 64 * ih + 32 * ib + r; const f32x4 qq = *(const LAS f32x4*)(SSQ + i * 4);
        const float rs = rsqrtf(((qq.x + qq.y) + (qq.z + qq.w)) * (1.f / GW) + RMS_EPS);
#pragma unroll
        for (int cb = 0; cb < 2; ++cb)
#pragma unroll
            for (int g4 = 0; g4 < 4; ++g4) { v2u o; o.x = pk2(acc[cb][ib][4 * g4] * rs, acc[cb][ib][4 * g4 + 1] * rs); o.y = pk2(acc[cb][ib][4 * g4 + 2] * rs, acc[cb][ib][4 * g4 + 3] * rs);
                *(v2u*)(P.MIX() + (base + i) * D + 768 + 64 * g + 32 * cb + 8 * g4 + 4 * hh) = o; } }
    __syncthreads();
}
#undef UNP

constexpr int MOE_ITEMS = NE * 192;
__device__ __forceinline__ void moe_cvt_item(Frame& F, const Ptrs& P, int l, int it) {
    LAS float* scr = (LAS float*)(F.lds + F.wave * 16384);
    const int e = it / 192; int r = it % 192;
    if (r < 128) { const int which = r >> 6, q = r & 63, kb = q >> 2, nb = q & 3, j0 = 64 * nb, dr = 256 * (j0 >> 7) + 128 * which + (j0 & 127);
        p0_item((which ? P.w3() : P.w1()) + ((size_t)l * NE + e) * D * DE, DE, j0, 64 * kb, P.W13() + ((size_t)l * NE + e) * 512 * D, D, dr, dr + 32, nullptr, scr, F.lane); }
    else { r -= 128; const int kb = r >> 4, nb = r & 15; p0_item(P.w2() + ((size_t)l * NE + e) * DE * D, D, 64 * nb, 64 * kb, P.W2() + ((size_t)l * NE + e) * D * DE, DE, 64 * nb, 64 * nb + 32, nullptr, scr, F.lane); }
}
__device__ __forceinline__ void moe_cvt_tail(Frame& F, const Ptrs& P, int l, int part) {
    const int nwg = (T / 256) * (NPROJ / 256), rem = nwg % F.G, c = (int)blockIdx.x;
    int idx, stride;
    if (rem == 0) { idx = c * 8 + F.wave; stride = F.G * 8; } else { if (c < rem) return; idx = (c - rem) * 8 + F.wave; stride = (F.G - rem) * 8; }
    const int per = (MOE_ITEMS + stride - 1) / stride, half = per / 2;
    for (int k = part ? half : 0; k < (part ? per : half); ++k) { const int it = idx + k * stride; if (it < MOE_ITEMS) moe_cvt_item(F, P, l, it); }
    __syncthreads();
}

template <int MODE = 0>
__device__ __forceinline__ void mixer_phase(Frame& F, const Ptrs& P, int layer, int qslot, int u_lo = 0, int u_hi = 1 << 30) {
    constexpr int NU_ATT = NB * 8 * NH, NU = 2 * NU_ATT + NB * 16 + T / 128;
    unsigned* head = F.ctl + CW_QUEUE + 64 * qslot;
    unsigned nxt = 0u;
    if (F.tid == 0) nxt = __hip_atomic_fetch_add(head, 1u, RLX_AGENT);
    for (;;) {
        if (F.tid == 0) F.MISC[0] = nxt;
        __syncthreads();
        const int u = (int)F.MISC[0] + u_lo;
        if (u >= NU || u >= u_hi) break;
        if (F.tid == 0) nxt = __hip_atomic_fetch_add(head, 1u, RLX_AGENT);
        asm volatile("" : "+v"(F.tid)); F.lane = F.tid & 63;
        { int v = u;
            if (u >= NU_ATT && u < NU_ATT + NB * 16) v = 2 * NU_ATT + (u - NU_ATT); else if (u >= NU_ATT + NB * 16 && u < 2 * NU_ATT + NB * 16) v = u - NB * 16;
            if (v < NU_ATT) { const int qb = 7 - v / 64, bh = v % 64; attn_unit<false, MODE>(F, P, layer, bh >> 2, bh & 3, qb); }
            else if (v < 2 * NU_ATT) { const int v2 = v - NU_ATT, qb = 7 - v2 / 64, bh = v2 % 64; attn_unit<true, MODE>(F, P, layer, bh >> 2, bh & 3, qb); }
            else if (v < 2 * NU_ATT + NB * 16) sgu_unit<(MODE >= 10 ? MODE : 0)>(F, P, layer, v - 2 * NU_ATT);
            else conv_unit(F, P, layer, v - 2 * NU_ATT - NB * 16); }
        __syncthreads();
    }
}
__device__ __forceinline__ void norm_phase(Frame& F, const Ptrs& P) {
    const int gw = F.vcu * 8 + F.wave, NGW = F.G * 8, lane = F.lane;
    const float* SS = P.SS(); bf16* MIX = P.MIX();
    f32x4 q, qn; v4u v, vn;
    if (gw < T) { q = *(const f32x4*)(SS + (size_t)gw * 8 + 4 * (lane >> 5)); v = *(const v4u*)(MIX + (size_t)gw * D + 8 * lane); }
    for (int m = gw; m < T; m += NGW) {
        const int mn = m + NGW;
        if (mn < T) { qn = *(const f32x4*)(SS + (size_t)mn * 8 + 4 * (lane >> 5)); vn = *(const v4u*)(MIX + (size_t)mn * D + 8 * lane); }
        const float rs = rsqrtf(((q.x + q.y) + (q.z + q.w)) * (1.f / GW) + RMS_EPS);
        v.x = pk2(bflo(v.x) * rs, bfhi(v.x) * rs); v.y = pk2(bflo(v.y) * rs, bfhi(v.y) * rs); v.z = pk2(bflo(v.z) * rs, bfhi(v.z) * rs); v.w = pk2(bflo(v.w) * rs, bfhi(v.w) * rs);
        *(v4u*)(MIX + (size_t)m * D + 8 * lane) = v;
        q = qn; v = vn;
    }
}
constexpr int LC_PSTART = 0, LC_CNT = 33;
template <int MODE = 0>
__device__ __forceinline__ void router_phase(Frame& F, const Ptrs& P, int layer, int cslot) {
    const int lane = F.lane, w = F.wave, r = lane & 31, hh = lane >> 5;
    LAS int* lcnt = (LAS int*)(F.lds); LAS int* lbase = lcnt + 32; LAS float* red = (LAS float*)(F.lds + 4096);
    const bf16* RWh = P.RW() + (size_t)(layer * 2 + 0) * 64 * D; const bf16* RWl = P.RW() + (size_t)(layer * 2 + 1) * 64 * D;
    f32x4 g1[4], b1[4]; load_gb(g1, b1, P.ln1_g() + (size_t)layer * D, P.ln1_b() + (size_t)layer * D, lane); bf16* XN = P.XN();
    unsigned* gcnt = F.ctl + CW_CNT + 64 * cslot;
    WfRegs Rdummy;
    for (int ch = F.vcu; ch < T / 128; ch += F.G) {
        const int m0 = ch * 128;
        if (F.tid < 64) lcnt[F.tid] = 0;
        if (MODE != 2) {
            v2u cq[4], nq[4], cm[4], nm[4]; bf16* rb = XN + (size_t)(m0 + 16 * w) * D + 4 * lane; const bf16* mb = P.MOUT() + (size_t)(m0 + 16 * w) * D + 4 * lane;
#pragma unroll
            for (int j = 0; j < 4; ++j) { cq[j] = *(const v2u*)(rb + 256 * j); cm[j] = *(const v2u*)(mb + 256 * j); }
            for (int i = 0; i < 16; ++i) {
                if (i + 1 < 16) {
#pragma unroll
                    for (int j = 0; j < 4; ++j) { nq[j] = *(const v2u*)(rb + (size_t)(i + 1) * D + 256 * j); nm[j] = *(const v2u*)(mb + (size_t)(i + 1) * D + 256 * j); } }
                f32x4 cur[4];
#pragma unroll
                for (int j = 0; j < 4; ++j) cur[j] = (f32x4){ALPHA * bflo(cq[j].x) + bflo(cm[j].x), ALPHA * bfhi(cq[j].x) + bfhi(cm[j].x), ALPHA * bflo(cq[j].y) + bflo(cm[j].y), ALPHA * bfhi(cq[j].y) + bfhi(cm[j].y)};
                finish_row<0, false>(cur, g1, b1, nullptr, XN + (size_t)(m0 + 16 * w + i) * D, Rdummy, (f32x4){0.f, 0.f, 0.f, 0.f}, nullptr, lane);
#pragma unroll
                for (int j = 0; j < 4; ++j) { cq[j] = nq[j]; cm[j] = nm[j]; } }
        }
        VM_WAIT();
        __syncthreads();
        const int tok = m0 + 32 * (w & 3) + r;
        f32x16 a0 = f32x16{}, a1 = f32x16{};
        {
            const bf16* xr = XN + (size_t)tok * D + 512 * (w >> 2) + 8 * hh;
            const bf16* wh = RWh + (size_t)r * D + 512 * (w >> 2) + 8 * hh;
#pragma unroll 4
            for (int s = 0; s < (MODE == 1 ? 0 : 32); ++s) {
                const bf16x8 xv = *(const bf16x8*)(xr + 16 * s);
                const bf16x8 wh0 = *(const bf16x8*)(wh + 16 * s), wh1 = *(const bf16x8*)(wh + (size_t)32 * D + 16 * s);
                a0 = __builtin_amdgcn_mfma_f32_32x32x16_bf16(wh0, xv, a0, 0, 0, 0);
                a1 = __builtin_amdgcn_mfma_f32_32x32x16_bf16(wh1, xv, a1, 0, 0, 0);
            }
        }
        if (w >= 4) {
#pragma unroll
            for (int i = 0; i < 16; ++i) red[((w & 3) * 20 + i) * 64 + lane] = a0[i];
#pragma unroll
            for (int i = 0; i < 4; ++i) red[((w & 3) * 20 + 16 + i) * 64 + lane] = a1[i]; }
        __syncthreads();
        int e0 = 0, e1 = 0, rk0 = 0, rk1 = 0; float ga0 = 0.f, ga1 = 0.f;
        if (w < 4) {
#pragma unroll
            for (int i = 0; i < 16; ++i) a0[i] += red[(w * 20 + i) * 64 + lane];
#pragma unroll
            for (int i = 0; i < 4; ++i) a1[i] += red[(w * 20 + 16 + i) * 64 + lane];
            float lg[4];
#pragma unroll
            for (int i = 0; i < 4; ++i) { const float t = other_half(a1[i]); lg[i] = (hh ? t : a1[i]) + P.rgb()[layer * 4 + i]; }
            int gs = 0; float mx = lg[0];
#pragma unroll
            for (int i = 1; i < 4; ++i) if (lg[i] > mx) { mx = lg[i]; gs = i; }
            float den = 0.f;
#pragma unroll
            for (int i = 0; i < 4; ++i) den += __expf(lg[i] - mx);
            const float pg = 1.0f / den;
            float own[4], oth[4], v[8];
#pragma unroll
            for (int k = 0; k < 4; ++k) { float t = a0[k];
#pragma unroll
                for (int g = 1; g < 4; ++g) if (gs == g) t = a0[4 * g + k];
                own[k] = t; oth[k] = other_half(t); }
#pragma unroll
            for (int k = 0; k < 4; ++k) { v[k] = hh ? oth[k] : own[k]; v[4 + k] = hh ? own[k] : oth[k]; }
            float m2 = -1e30f;
#pragma unroll
            for (int k = 0; k < 8; ++k) { v[k] += P.reb()[layer * 32 + gs * 8 + k]; m2 = fmaxf(m2, v[k]); }
            float p[8], ds = 0.f;
#pragma unroll
            for (int k = 0; k < 8; ++k) { p[k] = __expf(v[k] - m2); ds += p[k]; }
            int i0 = 0; float p0 = -1.f;
#pragma unroll
            for (int k = 0; k < 8; ++k) { p[k] = p[k] / ds; if (p[k] > p0) { p0 = p[k]; i0 = k; } }
            int i1 = 0; float p1 = -1.f;
#pragma unroll
            for (int k = 0; k < 8; ++k) if (k != i0 && p[k] > p1) { p1 = p[k]; i1 = k; }
            const float sm = p0 + p1;
            e0 = gs * 8 + i0; e1 = gs * 8 + i1; ga0 = pg * p0 / sm; ga1 = pg * p1 / sm;
            if (hh == 0) { rk0 = __hip_atomic_fetch_add(lcnt + e0, 1, __ATOMIC_RELAXED, __HIP_MEMORY_SCOPE_WORKGROUP); rk1 = __hip_atomic_fetch_add(lcnt + e1, 1, __ATOMIC_RELAXED, __HIP_MEMORY_SCOPE_WORKGROUP); }
        }
        __syncthreads();
        if (F.tid < 32) { const int c = lcnt[F.tid]; lbase[F.tid] = c ? (int)__hip_atomic_fetch_add(gcnt + F.tid, (unsigned)c, RLX_AGENT) : 0; }
        __syncthreads();
        if (w < 4 && hh == 0) { const int s0 = lbase[e0] + rk0, s1 = lbase[e1] + rk1;
            P.TE()[2 * tok] = e0; P.TE()[2 * tok + 1] = e1; P.TS()[2 * tok] = s0; P.TS()[2 * tok + 1] = s1; P.TG()[2 * tok] = ga0; P.TG()[2 * tok + 1] = ga1;
            P.RT()[(size_t)e0 * ECAP + s0] = tok; P.RT()[(size_t)e1 * ECAP + s1] = tok; }
        __syncthreads();
    }
}

__device__ __forceinline__ void moe_setup(Frame& F, int cslot) {
    volatile LAS int* lc = (volatile LAS int*)(F.lds + LDSCTL_OFF);
    if (F.tid == 0) { int run = 0;
        for (int e = 0; e < NE; ++e) { const int c = (int)__hip_atomic_load(F.ctl + CW_CNT + 64 * cslot + e, RLX_AGENT); lc[LC_CNT + e] = c; lc[LC_PSTART + e] = run; run += (c + 255) >> 8; }
        lc[LC_PSTART + NE] = run; }
    __syncthreads();
}
constexpr bool MOE_HYBRID = false;
struct MoeSched {
    volatile LAS int* lc; int G, c, mode; const char* A; const char* Wt; const int* RT; unsigned* gate;
    static constexpr bool HOOKS = true;
    __device__ bool next(int i, pg8::Unit& u) const {
        const int npb = lc[LC_PSTART + NE], nu = 2 * npb, nlu = MOE_HYBRID ? nu % G : 0, nua = nu - nlu;
        int pblk, pn; u.dep = 0; u.sig = 0;
        if (mode == 0) { const int L = i * G + c; if (L >= nua) return false; pblk = L >> 1; pn = L & 1; }
        else if (mode == 1) { if (i > 0 || c >= nlu) return false; const int L = nua + c; pblk = L >> 1; pn = L & 1; u.sig = 1; }
        else { const int gh = G - nlu; const int q = (c >= nlu) ? (i < 3 ? i * gh + (c - nlu) : 3 * gh + (i - 3) * G + c) : (3 * gh + i * G + c);
            if (q >= 4 * npb) return false; pblk = q >> 2; pn = q & 3; u.dep = (2 * pblk >= nua) ? 1 : 0; }
        int e = 0; while (lc[LC_PSTART + e + 1] <= pblk) ++e;
        const int blk = pblk - lc[LC_PSTART + e];
        u.pm = pblk; u.pn = pn;
        if (mode < 2) { u.a = A; u.rows = RT + (size_t)e * ECAP + blk * 256; const int n = lc[LC_CNT + e] - blk * 256; u.nrows = n < 256 ? n : 256; u.b = Wt + ((size_t)e * 512 + pn * 256) * D * 2; }
        else { u.a = A + (size_t)pblk * 256 * DE * 2; u.rows = nullptr; u.nrows = 256; u.b = Wt + ((size_t)e * D + pn * 256) * DE * 2; }
        return true;
    }
    __device__ __forceinline__ void done(const pg8::Unit& u) const {
        if (u.sig) { asm volatile("s_waitcnt vmcnt(0)" ::: "memory");
            if ((threadIdx.x & 63) == 0) { __builtin_amdgcn_fence(__ATOMIC_RELEASE, "agent"); asm volatile("s_waitcnt vmcnt(0)" ::: "memory"); __hip_atomic_fetch_add(gate, 1u, RLX_AGENT); } }
    }
    __device__ __forceinline__ void a_ready(const pg8::Unit& u) const {
        if (u.dep) { const int npb = lc[LC_PSTART + NE], nlu = MOE_HYBRID ? (2 * npb) % G : 0; const unsigned want = 8u * (unsigned)nlu;
            unsigned spins = 0u;
            while (__hip_atomic_load(gate, RLX_AGENT) < want && ++spins < (1u << 22)) __builtin_amdgcn_s_sleep(4);
            __builtin_amdgcn_fence(__ATOMIC_ACQUIRE, "agent"); asm volatile("s_waitcnt vmcnt(0)" ::: "memory"); }
    }
};

template <bool LFL>
__device__ __forceinline__ void combine_phase(Frame& F, const Ptrs& P, int layer, float* Xo) {
    volatile LAS int* lc = (volatile LAS int*)(F.lds + LDSCTL_OFF);
    WfRegs R; if (LFL) load_wf(R, P.w_in() + (size_t)(layer + 1) * D * PWIN, F.lane);
    f32x4 g2[4], b2[4]; load_gb(g2, b2, P.ln2_g() + (size_t)layer * D, P.ln2_b() + (size_t)layer * D, F.lane); const f32x4 bf = LFL ? *(const f32x4*)(P.b_f() + (layer + 1) * 4) : (f32x4){0.f, 0.f, 0.f, 0.f};
    const int gw = F.vcu * 8 + F.wave, NGW = F.G * 8, lane = F.lane;
    const int* TE = P.TE(); const int* TS = P.TS(); const float* TG = P.TG(); const bf16* O = P.O(); bf16* XN = P.XN(); float* LF = P.LF();
    struct Meta { v2u e, s; f32x2 g; }; struct Data { v2u x[4], a[4], b[4]; };
#define LD_META(M, m) do { (M).e = *(const v2u*)(TE + 2 * (size_t)(m)); (M).s = *(const v2u*)(TS + 2 * (size_t)(m)); (M).g = *(const f32x2*)(TG + 2 * (size_t)(m)); } while (0)
#define LD_DATA(Dd, M, m) do { const size_t r0_ = (size_t)lc[LC_PSTART + (int)(M).e.x] * 256 + (M).s.x, r1_ = (size_t)lc[LC_PSTART + (int)(M).e.y] * 256 + (M).s.y; \
        _Pragma("unroll") for (int j = 0; j < 4; ++j) { (Dd).x[j] = *(const v2u*)(XN + (size_t)(m) * D + 4 * lane + 256 * j); (Dd).a[j] = *(const v2u*)(O + r0_ * D + 4 * lane + 256 * j); (Dd).b[j] = *(const v2u*)(O + r1_ * D + 4 * lane + 256 * j); } } while (0)
    Meta M0, M1, M2; Data D0, D1;
    if (gw < T) { LD_META(M0, gw); LD_DATA(D0, M0, gw); }
    if (gw + NGW < T) LD_META(M1, gw + NGW);
    for (int m = gw; m < T; m += NGW) {
        if (m + 2 * NGW < T) LD_META(M2, m + 2 * NGW);
        if (m + NGW < T) LD_DATA(D1, M1, m + NGW);
        f32x4 v[4]; const float ga0 = M0.g.x, ga1 = M0.g.y;
#pragma unroll
        for (int j = 0; j < 4; ++j) { const v2u xq = D0.x[j]; const f32x4 x = {bflo(xq.x), bfhi(xq.x), bflo(xq.y), bfhi(xq.y)}; const v2u a = D0.a[j], b = D0.b[j];
            v[j].x = ALPHA * x.x + ga0 * bflo(a.x) + ga1 * bflo(b.x); v[j].y = ALPHA * x.y + ga0 * bfhi(a.x) + ga1 * bfhi(b.x);
            v[j].z = ALPHA * x.z + ga0 * bflo(a.y) + ga1 * bflo(b.y); v[j].w = ALPHA * x.w + ga0 * bfhi(a.y) + ga1 * bfhi(b.y); }
        finish_row<LFL ? 1 : 0, !LFL, LFL>(v, g2, b2, Xo + (size_t)m * D, XN + (size_t)m * D, R, bf, LF + (size_t)m * 4, lane);
        M0 = M1; M1 = M2; D0 = D1;
    }
#undef LD_META
#undef LD_DATA
}

__global__ void __launch_bounds__(512, 2) mk_fwd(Args args) {
    extern __shared__ __attribute__((aligned(16))) unsigned char lds[];
    Frame F;
    F.lds = (LAS unsigned char*)lds; F.lds_gen = lds;
    F.MISC = (volatile LAS unsigned*)(F.lds + MISC_OFF);
    F.tid = threadIdx.x; F.lane = F.tid & 63; F.wave = __builtin_amdgcn_readfirstlane(F.tid >> 6);
    F.G = gridDim.x; { const int bx = blockIdx.x; F.vcu = (F.G % 8 == 0) ? (bx % 8) * (F.G / 8) + bx / 8 : bx; }
    F.ws = args.ws; F.X = args.out; F.ctl = (unsigned*)(args.ws + WS_CTL);
    for (int u = F.tid; u < (LDS_BYTES - LDSCTL_OFF) / 4; u += 512) ((LAS unsigned*)(F.lds + LDSCTL_OFF))[u] = 0u;
    __syncthreads();
    if (F.tid < 24) { const unsigned long long pv = (unsigned long long)args.in[F.tid]; ((LAS unsigned*)(F.lds + PTAB_OFF))[2 * F.tid] = (unsigned)pv; ((LAS unsigned*)(F.lds + PTAB_OFF))[2 * F.tid + 1] = (unsigned)(pv >> 32); }
    __syncthreads();
    Ptrs P; P.tab = (volatile LAS unsigned*)(F.lds + PTAB_OFF); P.ws = args.ws;
    XcdBarrier bar = xcd_barrier_post(F.ctl + CW_BAR, F.MISC + 8);
    const int hi = args.ph_hi; int ph = 0;
#define PHASE_END() do { ++ph; if (ph >= hi) return; xcd_barrier(bar); asm volatile("" : "+v"(F.tid)); F.lane = F.tid & 63; F.wave = __builtin_amdgcn_readfirstlane(F.tid >> 6); } while (0)

#define RUN_P0() do { p0_weights(F, P); p0_rows(F, P); } while (0)
#define RUN_G1(layer) do { for (int bh = F.G - 1 - (int)blockIdx.x; bh < NB * NH; bh += F.G) c2_scan(F, P, bh); pg8::StaticOrder So; So.init(P.XN(), P.WIN() + (size_t)(layer) * NPROJ * D, T, NPROJ, D, F.G, (int)blockIdx.x); EpiProj E{P.PROJ(), F.ctl + CW_KINF + 128 * (layer)}; \
        pg8::gemm_phase<EpiProj, pg8::StaticOrder, false>(F.lds, D, So, E, F.tid); moe_cvt_tail(F, P, layer, 0); moe_cvt_tail(F, P, layer, 1); } while (0)
#define RUN_G2(layer) do { pg8::StaticOrder So; So.init(P.MIX(), P.WOUT() + (size_t)(layer) * D * D, T, D, D, F.G, (int)blockIdx.x); EpiRes E{P.MOUT(), P.SS(), (LAS float*)(F.lds + LDSCTL_OFF + 2048)}; \
        pg8::gemm_phase<EpiRes, pg8::StaticOrder, false>(F.lds, D, So, E, F.tid); } while (0)
#define RUN_U(layer, cslot, gslot) do { moe_setup(F, cslot); MoeSched Ms{(volatile LAS int*)(F.lds + LDSCTL_OFF), F.G, F.vcu, 0, (const char*)P.XN(), (const char*)(P.W13() + (size_t)(layer) * NE * 512 * D), P.RT(), F.ctl + CW_GATE + 64 * (gslot)}; EpiSwiglu E{P.H()}; \
        pg8::gemm_phase<EpiSwiglu, MoeSched, true>(F.lds, D, Ms, E, F.tid); } while (0)
#define RUN_DN(layer, gslot) do { { MoeSched Ml{(volatile LAS int*)(F.lds + LDSCTL_OFF), F.G, F.vcu, 1, (const char*)P.XN(), (const char*)(P.W13() + (size_t)(layer) * NE * 512 * D), P.RT(), F.ctl + CW_GATE + 64 * (gslot)}; EpiSwiglu El{P.H()}; \
        pg8::gemm_phase<EpiSwiglu, MoeSched, true>(F.lds, D, Ml, El, F.tid); } \
        MoeSched Ms{(volatile LAS int*)(F.lds + LDSCTL_OFF), F.G, F.vcu, 2, (const char*)P.H(), (const char*)(P.W2() + (size_t)(layer) * NE * D * DE), nullptr, F.ctl + CW_GATE + 64 * (gslot)}; EpiBf E{P.O()}; \
        pg8::gemm_phase<EpiBf, MoeSched, false>(F.lds, DE, Ms, E, F.tid); } while (0)
    RUN_P0();
    PHASE_END();
#define LAYER_BODY(layer, LAST) do { \
        RUN_G1(layer); PHASE_END(); \
        mixer_phase(F, P, layer, layer); PHASE_END(); \
        RUN_G2(layer); PHASE_END(); \
        router_phase(F, P, layer, layer); PHASE_END(); \
        RUN_U(layer, layer, layer); PHASE_END(); \
        RUN_DN(layer, layer); PHASE_END(); \
        if (!(LAST)) { combine_phase<true>(F, P, layer, nullptr); PHASE_END(); } else combine_phase<false>(F, P, layer, F.X); } while (0)
    LAYER_BODY(0, false);
    LAYER_BODY(1, true);
#if MK_XP
    {
        float* Xd = (float*)(F.ws + WS_PROJ);
        for (int rep = 0; rep < MK_XR; ++rep) {
            const int sl = 2 + rep; PHASE_END();
            if (MK_XP & 2048) { for (int q = 0; q < 10; ++q) PHASE_END(); }
            if (MK_XP & 1) { RUN_P0(); PHASE_END(); }
            if (MK_XP & 2) { RUN_G1(1); PHASE_END(); }
            if (MK_XP & 4) { mixer_phase<MK_AMODE>(F, P, 1, sl, MK_ULO, MK_UHI); PHASE_END(); }
            if (MK_XP & 8) { norm_phase(F, P); PHASE_END(); }
            if (MK_XP & 16) { RUN_G2(1); PHASE_END(); }
            if (MK_XP & 32) { router_phase<MK_RMODE>(F, P, 1, sl); PHASE_END(); }
            if (MK_XP & 64) { RUN_U(1, 1, sl); PHASE_END(); }
            if (MK_XP & 512) { moe_setup(F, 1); MoeSched Ms{(volatile LAS int*)(F.lds + LDSCTL_OFF), F.G, F.vcu, 0, (const char*)P.XN(), (const char*)(P.W13() + (size_t)(1) * NE * 512 * D), P.RT(), F.ctl + CW_GATE + 64 * sl}; EpiNone E{(float*)P.H()};
                pg8::gemm_phase<EpiNone, MoeSched, true>(F.lds, D, Ms, E, F.tid); PHASE_END(); }
            if (MK_XP & 1024) { pg8::StaticOrder So; So.init(P.XN(), P.WIN() + (size_t)(1) * NPROJ * D, T, NPROJ, D, F.G, (int)blockIdx.x); EpiNone E{(float*)P.H()};
                pg8::gemm_phase<EpiNone, pg8::StaticOrder, false>(F.lds, D, So, E, F.tid); PHASE_END(); }
            if (MK_XP & 128) { RUN_DN(1, sl); PHASE_END(); }
            if (MK_XP & 256) { moe_setup(F, 1); combine_phase<false>(F, P, 1, Xd); }
        }
    }
#endif
#undef PHASE_END
}

extern "C" void kernel_launch(void* const* d_in, const int* in_sizes, int n_in, void* d_out, int out_size, void* d_ws, size_t ws_size, hipStream_t stream) {
    static int grid = 0;
    if (grid == 0) {
        if (n_in != 24 || out_size != T * D || ws_size < WS_END) { fprintf(stderr, "kernel_launch: unexpected problem (n_in %d out %d ws %zu)\n", n_in, out_size, ws_size); grid = -1; return; }
        int dev = 0, cus = 0;
        if (hipGetDevice(&dev) != hipSuccess || hipDeviceGetAttribute(&cus, hipDeviceAttributeMultiprocessorCount, dev) != hipSuccess) { grid = -1; return; }
        if (hipFuncSetAttribute((const void*)mk_fwd, hipFuncAttributeMaxDynamicSharedMemorySize, LDS_BYTES) != hipSuccess) { fprintf(stderr, "kernel_launch: hipFuncSetAttribute failed\n"); grid = -1; return; }
        int per_cu = 0; (void)hipOccupancyMaxActiveBlocksPerMultiprocessor(&per_cu, (const void*)mk_fwd, 512, LDS_BYTES); (void)hipGetLastError();
        if (per_cu < 1) fprintf(stderr, "kernel_launch: occupancy query says %d blocks/CU\n", per_cu);
        grid = cus;
    }
    if (grid < 0) return;
    (void)hipMemsetAsync((char*)d_ws + WS_CTL, 0, CTL_ZERO_BYTES, stream);
    Args a{};
    for (int i = 0; i < 24; ++i) a.in[i] = (const float*)d_in[i];
    a.out = (float*)d_out; a.ws = (unsigned char*)d_ws; a.ph_lo = 0; a.ph_hi = MK_PH_HI;
    hipLaunchKernelGGL(mk_fwd, dim3(grid), dim3(512), LDS_BYTES, stream, a);
#ifdef MK_DEBUG_TAIL
    MK_DEBUG_TAIL
#endif
}
```

```cpp
#ifndef MK_PH_HI
#define MK_PH_HI 1000
#endif
#ifndef MK_XP
#define MK_XP 0
#endif
#ifndef MK_XR
#define MK_XR 1
#endif
#ifndef MK_STAGGER_TICKS
#define MK_STAGGER_TICKS 1200
#endif
#ifndef MK_NT_STORE
#define MK_NT_STORE 0
#endif
#ifndef MK_AMODE
#define MK_AMODE 0
#endif
#ifndef MK_ROUTER_LO
#define MK_ROUTER_LO 0
#endif
#ifndef MK_RMODE
#define MK_RMODE 0
#endif
#ifndef MK_ULO
#define MK_ULO 0
#define MK_UHI 1000000
#endif
#include <hip/hip_runtime.h>
#include <cstdio>
#include <cstdint>
#include <cmath>

constexpr int D = 1024, NB = 16, S = 2048, T = NB * S, NL = 2;
constexpr int GW = 256, NH = 4, HD = 64, PWIN = 2820, NPROJ = 2816;
constexpr int NE = 32, DE = 256, ECAP = 65536, PMAX = 73728;
constexpr float LN_EPS = 1e-5f, RMS_EPS = 1e-6f;
constexpr float ALPHA = 1.4142135623730951f;
constexpr float LOG2E = 1.4426950408889634f;
constexpr float C2 = 0.125f * LOG2E;

namespace pg8 {
#define PG8_LAS __attribute__((address_space(3)))
typedef unsigned short bf16_t;
typedef short bf16x8 __attribute__((ext_vector_type(8)));
typedef float f32x4 __attribute__((ext_vector_type(4)));
typedef float f32x2 __attribute__((ext_vector_type(2)));
typedef unsigned u32x4 __attribute__((ext_vector_type(4)));
constexpr int BM = 256, BK = 64, HALF = 128, HTB = HALF * BK * 2, STAGE_BYTES = 8 * HTB, NXCD = 8, WGM = 8;

__host__ __device__ __forceinline__ int lds_byte(int r, int c) { const int st = (r >> 4) * 2 + (c >> 5), rr = r & 15, cc = c & 31, ob = rr * 64 + cc * 2; return st * 1024 + (ob ^ (((ob >> 9) & 1) << 5)); }
__host__ __device__ __forceinline__ void stage_rc(int b, int& R, int& C) { const int st = b / 1024, sb = b % 1024, swz = sb ^ (((sb >> 9) & 1) << 5); R = (st >> 1) * 16 + swz / 64; C = (st & 1) * 32 + (swz % 64) / 2; }
__host__ __device__ __forceinline__ int perm32(int rho) { const int n = rho >> 4, i = rho & 15; return 8 * (i >> 2) + 4 * n + (i & 3); }

struct Unit { int pm, pn; const char* a; const char* b; const int* rows; int nrows; int dep, sig; };

__device__ __forceinline__ unsigned cvt_pk_bf16(float lo, float hi) { unsigned r; asm volatile("v_cvt_pk_bf16_f32 %0, %1, %2" : "=v"(r) : "v"(lo), "v"(hi)); return r; }

struct StaticOrder {
    int nM, nN, nwg, G, c; const char* A; const char* Bt; size_t tstep;
    __device__ void init(const void* A_, const void* Bt_, int M, int N, int K, int G_, int c_) { nM = M / BM; nN = N / BM; nwg = nM * nN; G = G_; c = c_; A = (const char*)A_; Bt = (const char*)Bt_; tstep = (size_t)BM * K * 2; }
    __device__ bool next(int i, Unit& u) const {
        const long L = (long)i * G + c; if (L >= nwg) return false;
        int wgid = (int)L; { const int q = nwg / NXCD, r = nwg % NXCD, xcd = wgid % NXCD, off = wgid / NXCD; wgid = (xcd < r ? xcd * (q + 1) : r * (q + 1) + (xcd - r) * q) + off; }
        const int nig = WGM * nN, gid = wgid / nig, fm = gid * WGM, gsz = (nM - fm) < WGM ? (nM - fm) : WGM;
        u.pm = fm + ((wgid % nig) % gsz); u.pn = (wgid % nig) / gsz; u.a = A + (size_t)u.pm * tstep; u.b = Bt + (size_t)u.pn * tstep; u.rows = nullptr; u.nrows = BM; u.dep = 0; u.sig = 0; return true;
    }
    static constexpr bool HOOKS = false;
    __device__ __forceinline__ void a_ready(const Unit&) const {}
    __device__ __forceinline__ void done(const Unit&) const {}
};

template <class Epi, class Sched, bool GATHER, bool ALIGN_EPI = true>
__device__ __forceinline__ void gemm_phase(PG8_LAS unsigned char* lds, const int K, const Sched& S, const Epi& E, const int tid) {
    const int wid = __builtin_amdgcn_readfirstlane(tid >> 6), lane = tid & 63, wr = wid >> 2, wc = wid & 3, fr = lane & 15, fq = lane >> 4;
    const int nt = K / BK;
    unsigned voffA[2][2], voffB[2];
#pragma unroll
    for (int i = 0; i < 2; ++i) { int R, C; stage_rc(tid * 16 + i * 8192, R, C); const int Rb = Epi::PERM ? ((R & ~31) + perm32(R & 31)) : R;
        voffA[0][i] = (unsigned)(R * K + C) * 2u; voffA[1][i] = (unsigned)((R + HALF) * K + C) * 2u; voffB[i] = (unsigned)(Rb * K + C) * 2u; }
    const size_t kstep = (size_t)(BK * 2);
    const size_t hstep = (size_t)HALF * K * 2;
    const unsigned ldsw = (unsigned)wid * 1024u;
    const int aoff = lds_byte(wr * 64 + fr, fq * 8), boff = lds_byte(wc * 32 + fr, fq * 8);
#define PG8_SA(b, h) (((b) * 2 + (h)) * HTB)
#define PG8_SB(b, h) ((4 + (b) * 2 + (h)) * HTB)
#define PG8_STAGE(bufoff, gbase, voff) do { _Pragma("unroll") for (int _i = 0; _i < 2; ++_i) \
        __builtin_amdgcn_global_load_lds((const unsigned*)((const char*)(gbase) + (voff)[_i]), (PG8_LAS unsigned*)(lds + (bufoff) + ldsw + _i * 8192), 16, 0, 0); } while (0)
#define PG8_LDA(dst, b, h) do { _Pragma("unroll") for (int m = 0; m < 4; ++m) _Pragma("unroll") for (int k = 0; k < 2; ++k) dst[m][k] = *(const PG8_LAS bf16x8*)(lds + PG8_SA(b, h) + aoff + m * 2048 + k * 1024); } while (0)
#define PG8_LDB(dst, b, h) do { _Pragma("unroll") for (int n = 0; n < 2; ++n) _Pragma("unroll") for (int k = 0; k < 2; ++k) dst[n][k] = *(const PG8_LAS bf16x8*)(lds + PG8_SB(b, h) + boff + n * 2048 + k * 1024); } while (0)
#define PG8_MMA(ai, bj, At, Bt) do { __builtin_amdgcn_s_setprio(1); _Pragma("unroll") for (int m = 0; m < 4; ++m) _Pragma("unroll") for (int n = 0; n < 2; ++n) _Pragma("unroll") for (int k = 0; k < 2; ++k) \
        acc[ai][bj][m][n] = __builtin_amdgcn_mfma_f32_16x16x32_bf16(Bt[n][k], At[m][k], acc[ai][bj][m][n], 0, 0, 0); __builtin_amdgcn_s_setprio(0); } while (0)
#define PG8_WAIT_V(n) asm volatile("s_waitcnt vmcnt(" #n ")" ::: "memory")
#define PG8_WAIT_L(n) asm volatile("s_waitcnt lgkmcnt(" #n ")" ::: "memory")
#define PG8_BAR __builtin_amdgcn_s_barrier()
#define PG8_SCHED __builtin_amdgcn_sched_barrier(0)
#define PG8_GLOAD(ids, u) do { int _t2 = tid; asm volatile("" : "+v"(_t2)); _Pragma("unroll") for (int _i = 0; _i < 2; ++_i) { int _R, _C; stage_rc(_t2 * 16 + _i * 8192, _R, _C); \
        _Pragma("unroll") for (int _h = 0; _h < 2; ++_h) { const int _r = _R + _h * HALF; ids[_h][_i] = (_r < (u).nrows) ? (u).rows[_r] : 0; } } } while (0)
#define PG8_GSET(dst, ids) do { int _t2 = tid; asm volatile("" : "+v"(_t2)); _Pragma("unroll") for (int _i = 0; _i < 2; ++_i) { int _R, _C; stage_rc(_t2 * 16 + _i * 8192, _R, _C); \
        _Pragma("unroll") for (int _h = 0; _h < 2; ++_h) dst[_h][_i] = (unsigned)(ids[_h][_i] * K + _C) * 2u; } } while (0)
    Unit cur, nxt; int ui = 0;
    if (!S.next(0, cur)) return;
    f32x4 acc[2][2][4][2];
#pragma unroll
    for (int a = 0; a < 2; ++a)
#pragma unroll
        for (int b = 0; b < 2; ++b)
#pragma unroll
            for (int m = 0; m < 4; ++m)
#pragma unroll
                for (int n = 0; n < 2; ++n) acc[a][b][m][n] = (f32x4){0.f, 0.f, 0.f, 0.f};
    bf16x8 At[4][2], B0[2][2], B1[2][2];
    const char* cA = cur.a; const char* cB = cur.b;
    if constexpr (Sched::HOOKS) S.a_ready(cur);
    int gids[2][2];
    if constexpr (GATHER) { PG8_GLOAD(gids, cur); PG8_GSET(voffA, gids); }
    PG8_STAGE(PG8_SB(0, 0), cB, voffB); PG8_STAGE(PG8_SB(0, 1), cB + hstep, voffB); PG8_STAGE(PG8_SA(0, 0), cA, voffA[0]); PG8_STAGE(PG8_SA(0, 1), cA, voffA[1]);
    if (wr == 1) PG8_BAR;
    PG8_WAIT_V(2); PG8_BAR;
    PG8_STAGE(PG8_SB(1, 0), cB + kstep, voffB); PG8_STAGE(PG8_SA(1, 0), cA + kstep, voffA[0]); PG8_STAGE(PG8_SB(1, 1), cB + hstep + kstep, voffB);
    PG8_WAIT_V(6); PG8_BAR;
    for (;;) {
        const bool has_next = S.next(ui + 1, nxt);
        if constexpr (Epi::KSCALE) E.kscale_begin(cur, tid);
        if constexpr (GATHER) { if (has_next) { PG8_GLOAD(gids, nxt); } }
        const char* nA = has_next ? nxt.a : cA; const char* nB = has_next ? nxt.b : cB;
#pragma nounroll
        for (int t = 0; t < nt; t += 2) {
            const bool last = (t == nt - 2);
            const char* a1 = cA + (size_t)(t + 1) * kstep;
            const char* a2 = last ? nA : cA + (size_t)(t + 2) * kstep; const char* b2 = last ? nB : cB + (size_t)(t + 2) * kstep;
            const char* a3 = a2 + kstep; const char* b3 = b2 + kstep;
            if constexpr (Sched::HOOKS) { if (last && has_next) S.a_ready(nxt); }
            PG8_LDB(B0, 0, 0); PG8_LDB(B1, 0, 1); PG8_SCHED; PG8_LDA(At, 0, 0); PG8_STAGE(PG8_SA(1, 1), a1, voffA[1]);
            if constexpr (GATHER) { if (last && has_next) { PG8_GSET(voffA, gids); } }
            PG8_WAIT_V(8); PG8_WAIT_L(0); PG8_BAR; PG8_MMA(0, 0, At, B0); PG8_MMA(0, 1, At, B1); PG8_BAR; PG8_SCHED;
            PG8_LDA(At, 0, 1); PG8_STAGE(PG8_SB(0, 0), b2, voffB); PG8_STAGE(PG8_SB(0, 1), b2 + hstep, voffB); PG8_STAGE(PG8_SA(0, 0), a2, voffA[0]);
            PG8_WAIT_V(8); PG8_WAIT_L(0); PG8_BAR; PG8_MMA(1, 0, At, B0); PG8_MMA(1, 1, At, B1); PG8_BAR; PG8_SCHED;
            PG8_LDB(B0, 1, 0); PG8_LDB(B1, 1, 1); PG8_SCHED; PG8_LDA(At, 1, 0); PG8_STAGE(PG8_SA(0, 1), a2, voffA[1]);
            PG8_WAIT_V(8); PG8_WAIT_L(0); PG8_BAR; PG8_MMA(0, 0, At, B0); PG8_MMA(0, 1, At, B1); PG8_BAR; PG8_SCHED;
            PG8_LDA(At, 1, 1); PG8_STAGE(PG8_SB(1, 0), b3, voffB); PG8_STAGE(PG8_SB(1, 1), b3 + hstep, voffB); PG8_STAGE(PG8_SA(1, 0), a3, voffA[0]);
            PG8_WAIT_V(8); PG8_WAIT_L(0); PG8_BAR; PG8_MMA(1, 0, At, B0); PG8_MMA(1, 1, At, B1); PG8_BAR; PG8_SCHED;
            if constexpr (Epi::KSCALE) { if (t == 2 || t == 6) { PG8_SCHED; E.kscale(acc, t == 6 ? 1 : 0, wr, fr); PG8_SCHED; } }
        }
        if constexpr (ALIGN_EPI) { if (wr == 0) PG8_BAR; }
        E(acc, cur, wr, wc, fr, fq);
        if constexpr (Sched::HOOKS) S.done(cur);
        if (!has_next) break;
#pragma unroll
        for (int a = 0; a < 2; ++a)
#pragma unroll
            for (int b = 0; b < 2; ++b)
#pragma unroll
                for (int m = 0; m < 4; ++m)
#pragma unroll
                    for (int n = 0; n < 2; ++n) acc[a][b][m][n] = (f32x4){0.f, 0.f, 0.f, 0.f};
        cur = nxt; cA = nA; cB = nB; ++ui;
        if constexpr (ALIGN_EPI) { if (wr == 1) PG8_BAR; }
    }
    PG8_WAIT_V(0);
    if constexpr (!ALIGN_EPI) { if (wr == 0) PG8_BAR; }
    PG8_BAR;
#undef PG8_SA
#undef PG8_SB
#undef PG8_STAGE
#undef PG8_LDA
#undef PG8_LDB
#undef PG8_MMA
#undef PG8_WAIT_V
#undef PG8_WAIT_L
#undef PG8_BAR
#undef PG8_SCHED
#undef PG8_GLOAD
#undef PG8_GSET
}
}
#define GAS __attribute__((address_space(1)))
#define LAS __attribute__((address_space(3)))
typedef unsigned short bf16;
typedef unsigned v4u __attribute__((ext_vector_type(4)));
typedef unsigned v2u __attribute__((ext_vector_type(2)));
typedef float f32x4 __attribute__((ext_vector_type(4)));
typedef float f32x2 __attribute__((ext_vector_type(2)));
typedef float f32x16 __attribute__((ext_vector_type(16)));
typedef short bf16x8 __attribute__((ext_vector_type(8)));
typedef short s16x4 __attribute__((ext_vector_type(4)));
typedef GAS unsigned gu32;
#define RLX_AGENT __ATOMIC_RELAXED, __HIP_MEMORY_SCOPE_AGENT
#define LDS_WAIT() asm volatile("s_waitcnt lgkmcnt(0)" ::: "memory")
#define VM_WAIT() asm volatile("s_waitcnt vmcnt(0)" ::: "memory")
__device__ __forceinline__ unsigned f2bf(float f) { unsigned u = __builtin_bit_cast(unsigned, f); return (u + 0x7fffu + ((u >> 16) & 1u)) >> 16; }
typedef __bf16 bf16x2_t __attribute__((ext_vector_type(2)));
__device__ __forceinline__ unsigned pk2(float lo, float hi) { f32x2 v = {lo, hi}; bf16x2_t b = __builtin_convertvector(v, bf16x2_t); return __builtin_bit_cast(unsigned, b); }
__device__ __forceinline__ float bf2f(unsigned h) { return __builtin_bit_cast(float, h << 16); }
__device__ __forceinline__ float bflo(unsigned w) { return __builtin_bit_cast(float, w << 16); }
__device__ __forceinline__ float bfhi(unsigned w) { return __builtin_bit_cast(float, w & 0xffff0000u); }
template <int CTRL> __device__ __forceinline__ float dpp_mov(float v) { return __int_as_float(__builtin_amdgcn_update_dpp(0, __float_as_int(v), CTRL, 0xF, 0xF, true)); }
__device__ __forceinline__ float wave_sum(float v) {
    v += dpp_mov<0xB1>(v); v += dpp_mov<0x4E>(v); v += dpp_mov<0x141>(v); v += dpp_mov<0x140>(v);
    { auto s = __builtin_amdgcn_permlane16_swap(__float_as_uint(v), __float_as_uint(v), false, false); v = __uint_as_float(s[0]) + __uint_as_float(s[1]); }
    { auto s = __builtin_amdgcn_permlane32_swap(__float_as_uint(v), __float_as_uint(v), false, false); v = __uint_as_float(s[0]) + __uint_as_float(s[1]); }
    return v;
}
__device__ __forceinline__ float wave_max(float v) {
    v = fmaxf(v, dpp_mov<0xB1>(v)); v = fmaxf(v, dpp_mov<0x4E>(v)); v = fmaxf(v, dpp_mov<0x141>(v)); v = fmaxf(v, dpp_mov<0x140>(v));
    { auto s = __builtin_amdgcn_permlane16_swap(__float_as_uint(v), __float_as_uint(v), false, false); v = fmaxf(__uint_as_float(s[0]), __uint_as_float(s[1])); }
    { auto s = __builtin_amdgcn_permlane32_swap(__float_as_uint(v), __float_as_uint(v), false, false); v = fmaxf(__uint_as_float(s[0]), __uint_as_float(s[1])); }
    return v;
}
__device__ __forceinline__ float other_half(float x) {
    auto rr = __builtin_amdgcn_permlane32_swap(__float_as_uint(x), __float_as_uint(x), false, false);
    return __uint_as_float((threadIdx.x & 32) ? rr[0] : rr[1]);
}
__device__ __forceinline__ float log_sigmoid_f(float x) { return fminf(x, 0.f) - log1pf(__expf(-fabsf(x))); }
__device__ __forceinline__ float gelu_tanh_f(float x) {
    const float u = x * (1.0f + 0.044715f * x * x);
    const float e = __builtin_amdgcn_exp2f(u * (-2.0f * 0.7978845608028654f * LOG2E));
    return x * __builtin_amdgcn_rcpf(1.0f + e);
}

#if MK_NT_STORE
#define MK_STORE16(p, v) __builtin_nontemporal_store((v), (p))
#else
#define MK_STORE16(p, v) (*(p) = (v))
#endif
struct EpiProj {
    static constexpr bool PERM = true, KSCALE = false; static constexpr int NSTORE = 16;
    bf16* O; unsigned* kinf;
    __device__ __forceinline__ void operator()(const pg8::f32x4 (&acc)[2][2][4][2], const pg8::Unit& u, int wr, int wc, int fr, int fq) const {
        const int row0 = u.pm * 256 + wr * 64 + fr, col0 = u.pn * 256 + wc * 32 + 8 * fq;
        const float sc = (u.pn == 0 || u.pn == 3) ? C2 : 1.f; const bool g = u.pn >= 9;
        if (u.pn == 4) {
#pragma unroll
            for (int bj = 0; bj < 2; ++bj) { float mx = 0.f;
#pragma unroll
                for (int ai = 0; ai < 2; ++ai)
#pragma unroll
                    for (int m = 0; m < 4; ++m) { float s = 0.f;
#pragma unroll
                        for (int n = 0; n < 2; ++n)
#pragma unroll
                            for (int e = 0; e < 4; ++e) s += acc[ai][bj][m][n][e] * acc[ai][bj][m][n][e];
                        { auto t = __builtin_amdgcn_permlane16_swap(__float_as_uint(s), __float_as_uint(s), false, false); s = __uint_as_float(t[0]) + __uint_as_float(t[1]); }
                        { auto t = __builtin_amdgcn_permlane32_swap(__float_as_uint(s), __float_as_uint(s), false, false); s = __uint_as_float(t[0]) + __uint_as_float(t[1]); }
                        mx = fmaxf(mx, s); }
                mx = wave_max(mx);
                if ((threadIdx.x & 63) == 0) atomicMax(kinf + ((u.pm >> 3) * 4 + 2 * bj + (wc >> 1)) * 2 + (wc & 1), __float_as_uint(mx)); } }
        if (u.pn == 6 || u.pn == 7) {
#pragma unroll
            for (int ai = 0; ai < 2; ++ai)
#pragma unroll
                for (int m = 0; m < 4; ++m) { const pg8::f32x4 z0 = acc[ai][0][m][0] * acc[ai][1][m][0], z1 = acc[ai][0][m][1] * acc[ai][1][m][1];
                    v4u w; w.x = pg8::cvt_pk_bf16(z0[0], z0[1]); w.y = pg8::cvt_pk_bf16(z0[2], z0[3]); w.z = pg8::cvt_pk_bf16(z1[0], z1[1]); w.w = pg8::cvt_pk_bf16(z1[2], z1[3]);
                    *(v4u*)(O + (size_t)(row0 + ai * 128 + m * 16) * NPROJ + 1536 + 128 * (u.pn - 6) + wc * 32 + 8 * fq) = w; }
            return; }
#pragma unroll
        for (int ai = 0; ai < 2; ++ai)
#pragma unroll
            for (int m = 0; m < 4; ++m) { bf16* rowp = O + (size_t)(row0 + ai * 128 + m * 16) * NPROJ + col0;
#pragma unroll
                for (int bj = 0; bj < 2; ++bj) { pg8::f32x4 v0 = acc[ai][bj][m][0], v1 = acc[ai][bj][m][1];
                    if (g) {
#pragma unroll
                        for (int e = 0; e < 4; ++e) { v0[e] = gelu_tanh_f(v0[e]); v1[e] = gelu_tanh_f(v1[e]); } }
                    v0 = v0 * sc; v1 = v1 * sc; v4u w; w.x = pg8::cvt_pk_bf16(v0[0], v0[1]); w.y = pg8::cvt_pk_bf16(v0[2], v0[3]); w.z = pg8::cvt_pk_bf16(v1[0], v1[1]); w.w = pg8::cvt_pk_bf16(v1[2], v1[3]);
                    MK_STORE16((v4u*)(rowp + bj * 128), w); } }
    }
};
struct EpiRes {
    static constexpr bool PERM = true, KSCALE = true; static constexpr int NSTORE = 16;
    bf16* X; const float* SS; LAS float* tab;
    __device__ __forceinline__ void kscale_begin(const pg8::Unit& u, int tid) const {
        if (tid < 256) { const f32x4 a = *(const f32x4*)(SS + (size_t)(u.pm * 256 + tid) * 8), b = *(const f32x4*)(SS + (size_t)(u.pm * 256 + tid) * 8 + 4);
            const float rA = rsqrtf(((a.x + a.y) + (a.z + a.w)) * (1.f / GW) + RMS_EPS), rB = rsqrtf(((b.x + b.y) + (b.z + b.w)) * (1.f / GW) + RMS_EPS);
            *(LAS f32x2*)(tab + 2 * tid) = (f32x2){rA / rB, rB}; }
    }
    __device__ __forceinline__ void kscale(pg8::f32x4 (&acc)[2][2][4][2], int which, int wr, int fr) const {
#pragma unroll
        for (int ai = 0; ai < 2; ++ai)
#pragma unroll
            for (int m = 0; m < 4; ++m) { const float s = tab[2 * (ai * 128 + wr * 64 + m * 16 + fr) + which];
#pragma unroll
                for (int bj = 0; bj < 2; ++bj)
#pragma unroll
                    for (int n = 0; n < 2; ++n) acc[ai][bj][m][n] = acc[ai][bj][m][n] * s; }
    }
    __device__ __forceinline__ void operator()(const pg8::f32x4 (&acc)[2][2][4][2], const pg8::Unit& u, int wr, int wc, int fr, int fq) const {
        const int row0 = u.pm * 256 + wr * 64 + fr, col0 = u.pn * 256 + wc * 32 + 8 * fq;
#pragma unroll
        for (int ai = 0; ai < 2; ++ai)
#pragma unroll
            for (int m = 0; m < 4; ++m) { bf16* rowp = X + (size_t)(row0 + ai * 128 + m * 16) * D + col0;
#pragma unroll
                for (int bj = 0; bj < 2; ++bj) { const pg8::f32x4 v0 = acc[ai][bj][m][0], v1 = acc[ai][bj][m][1]; v4u w;
                    w.x = pg8::cvt_pk_bf16(v0[0], v0[1]); w.y = pg8::cvt_pk_bf16(v0[2], v0[3]); w.z = pg8::cvt_pk_bf16(v1[0], v1[1]); w.w = pg8::cvt_pk_bf16(v1[2], v1[3]);
                    *(v4u*)(rowp + bj * 128) = w; } }
    }
};
struct EpiSwiglu {
    static constexpr bool PERM = true, KSCALE = false; static constexpr int NSTORE = 8;
    bf16* Hh;
    __device__ __forceinline__ void operator()(const pg8::f32x4 (&acc)[2][2][4][2], const pg8::Unit& u, int wr, int wc, int fr, int fq) const {
        const int row0 = u.pm * 256 + wr * 64 + fr, col0 = u.pn * 128 + wc * 32 + 8 * fq;
#pragma unroll
        for (int ai = 0; ai < 2; ++ai)
#pragma unroll
            for (int m = 0; m < 4; ++m) { float h[8];
#pragma unroll
                for (int n = 0; n < 2; ++n)
#pragma unroll
                    for (int e = 0; e < 4; ++e) { const float a1 = acc[ai][0][m][n][e], a3 = acc[ai][1][m][n][e];
                        h[n * 4 + e] = a1 * __builtin_amdgcn_rcpf(1.0f + __builtin_amdgcn_exp2f(-LOG2E * a1)) * a3; }
                v4u w; w.x = pg8::cvt_pk_bf16(h[0], h[1]); w.y = pg8::cvt_pk_bf16(h[2], h[3]); w.z = pg8::cvt_pk_bf16(h[4], h[5]); w.w = pg8::cvt_pk_bf16(h[6], h[7]);
                *(v4u*)(Hh + (size_t)(row0 + ai * 128 + m * 16) * DE + col0) = w; }
    }
};
struct EpiBf {
    static constexpr bool PERM = true, KSCALE = false; static constexpr int NSTORE = 16;
    bf16* O;
    __device__ __forceinline__ void operator()(const pg8::f32x4 (&acc)[2][2][4][2], const pg8::Unit& u, int wr, int wc, int fr, int fq) const {
        const int row0 = u.pm * 256 + wr * 64 + fr, col0 = u.pn * 256 + wc * 32 + 8 * fq;
#pragma unroll
        for (int ai = 0; ai < 2; ++ai)
#pragma unroll
            for (int m = 0; m < 4; ++m) { bf16* rowp = O + (size_t)(row0 + ai * 128 + m * 16) * D + col0;
#pragma unroll
                for (int bj = 0; bj < 2; ++bj) { const pg8::f32x4 v0 = acc[ai][bj][m][0], v1 = acc[ai][bj][m][1];
                    v4u w; w.x = pg8::cvt_pk_bf16(v0[0], v0[1]); w.y = pg8::cvt_pk_bf16(v0[2], v0[3]); w.z = pg8::cvt_pk_bf16(v1[0], v1[1]); w.w = pg8::cvt_pk_bf16(v1[2], v1[3]);
                    *(v4u*)(rowp + bj * 128) = w; } }
    }
};

struct EpiNone {
    static constexpr bool PERM = true, KSCALE = false; static constexpr int NSTORE = 8; float* sink;
    __device__ __forceinline__ void operator()(const pg8::f32x4 (&acc)[2][2][4][2], const pg8::Unit& u, int wr, int wc, int fr, int fq) const {
        float s = 0.f;
#pragma unroll
        for (int ai = 0; ai < 2; ++ai)
#pragma unroll
            for (int bj = 0; bj < 2; ++bj)
#pragma unroll
                for (int m = 0; m < 4; ++m)
#pragma unroll
                    for (int n = 0; n < 2; ++n) s += acc[ai][bj][m][n][0] + acc[ai][bj][m][n][3];
        if (s == 12345.678f) sink[0] = s;
    }
};

constexpr size_t MiB = 1u << 20;
constexpr size_t WS_CTL = 0, CTL_ZERO_BYTES = 1 * MiB;
constexpr size_t WS_LF = 1 * MiB;
constexpr size_t WS_SS = 2 * MiB;
constexpr size_t WS_TE = 3 * MiB;
constexpr size_t WS_TS = WS_TE + 256 * 1024, WS_TG = WS_TS + 256 * 1024;
constexpr size_t WS_RT = 4 * MiB;
constexpr size_t WS_RW = 12 * MiB;
constexpr size_t WS_SGW = 13 * MiB;
constexpr size_t WS_GL = 15 * MiB;
constexpr size_t WS_C2 = 14 * MiB;
constexpr size_t WS_WIN = 16 * MiB;
constexpr size_t WS_WOUT = 27 * MiB;
constexpr size_t WS_W13 = 31 * MiB;
constexpr size_t WS_W2 = 95 * MiB;
constexpr size_t WS_XN = 128 * MiB;
constexpr size_t WS_MIX = 192 * MiB;
constexpr size_t WS_PROJ = 256 * MiB;
constexpr size_t WS_H = 432 * MiB;
constexpr size_t WS_END = 468 * MiB;
constexpr int CW_BAR = 4096;
constexpr int CW_QUEUE = 8192;
constexpr int CW_KINF = 9216;
constexpr int CW_GATE = 9472;
constexpr int CW_CNT = 8448;
constexpr int RING_BYTES = 131072, LDSCTL_OFF = RING_BYTES, MISC_OFF = LDSCTL_OFF + 320, LDS_BYTES = 147456;

#define XB_TMO      128
#define XB_XCNT(j)  (256  + 64 * (j))
#define XB_XSUB(j)  (1280 + 64 * (j))
#define XB_XGEN(j)  (2304 + 64 * (j))
#define XB_TOP      3328
#define XB_TOPGEN   3392
#define XCD_BAR_WORDS 3456
#define XB_SPIN_CAP (1u << 18)
__device__ __forceinline__ unsigned xb_ld(unsigned* p)              { return __hip_atomic_load(p, __ATOMIC_RELAXED, __HIP_MEMORY_SCOPE_AGENT); }
__device__ __forceinline__ unsigned xb_add(unsigned* p, unsigned v) { return __hip_atomic_fetch_add(p, v, __ATOMIC_RELAXED, __HIP_MEMORY_SCOPE_AGENT); }
__device__ __forceinline__ unsigned xb_xcc_id() { return (unsigned)__builtin_amdgcn_s_getreg((3 << 11) | 20) & 0xFu; }
#define XB_SPIN(cond, bar) do { unsigned _sp = 0; while (cond) { __builtin_amdgcn_s_sleep(1); \
    if ((++_sp & 255u) == 0u) { if (xb_ld(&(bar)[XB_TMO])) break; if (_sp > XB_SPIN_CAP) { atomicAdd(&(bar)[XB_TMO], 1u); break; } } } } while (0)
struct XcdBarrier { unsigned* bar; unsigned x; volatile LAS unsigned* st; };
__device__ __forceinline__ XcdBarrier xcd_barrier_post(unsigned* bar, volatile LAS unsigned* st) {
    XcdBarrier b; b.bar = bar; b.x = xb_xcc_id(); b.st = st;
    if (threadIdx.x == 0) (void)xb_add(&bar[XB_XCNT(b.x)], 1u);
    return b;
}
__device__ __forceinline__ void xcd_barrier_complete(unsigned* bar, unsigned x, unsigned& nloc, unsigned& nx) {
    const unsigned G = gridDim.x * gridDim.y * gridDim.z;
    unsigned sum, cnt, mine, sp = 0u;
    for (;;) {
        sum = 0u; cnt = 0u; mine = 0u;
#pragma unroll
        for (unsigned j = 0; j < 16; ++j) { const unsigned c = xb_ld(&bar[XB_XCNT(j)]); sum += c; cnt += (c > 0u) ? 1u : 0u; mine = (j == x) ? c : mine; }
        if (sum == G) break;
        __builtin_amdgcn_s_sleep(1);
        if ((++sp & 255u) == 0u) { if (xb_ld(&bar[XB_TMO])) break; if (sp > XB_SPIN_CAP) { atomicAdd(&bar[XB_TMO], 1u); break; } }
    }
    nloc = mine > 0u ? mine : 1u; nx = cnt > 0u ? cnt : 1u;
}
__device__ __forceinline__ void xcd_barrier(const XcdBarrier& b) {
    asm volatile("s_waitcnt vmcnt(0)" ::: "memory");
    __syncthreads();
    if (threadIdx.x == 0) {
        unsigned* bar = b.bar;
        __builtin_amdgcn_s_waitcnt(0);
        unsigned nloc = b.st[0], nx = b.st[1];
        if (nloc == 0u) { xcd_barrier_complete(bar, b.x, nloc, nx); b.st[0] = nloc; b.st[1] = nx; }
        const unsigned old = xb_add(&bar[XB_XSUB(b.x)], 1u);
        const unsigned gen = old / nloc;
        if (old + 1u == (gen + 1u) * nloc) {
            __builtin_amdgcn_fence(__ATOMIC_RELEASE, "agent");
            asm volatile("s_waitcnt vmcnt(0)" ::: "memory");
            const unsigned og = xb_add(&bar[XB_TOP], 1u);
            const unsigned tg = og / nx;
            if (og + 1u == (tg + 1u) * nx) xb_add(&bar[XB_TOPGEN], 1u);
            else XB_SPIN(xb_ld(&bar[XB_TOPGEN]) == tg, bar);
            __builtin_amdgcn_fence(__ATOMIC_ACQUIRE, "agent");
            xb_add(&bar[XB_XGEN(b.x)], 1u);
            asm volatile("s_waitcnt vmcnt(0)" ::: "memory");
        } else {
            XB_SPIN(xb_ld(&bar[XB_XGEN(b.x)]) == gen, bar);
            __builtin_amdgcn_fence(__ATOMIC_ACQUIRE, "agent");
            asm volatile("s_waitcnt vmcnt(0)" ::: "memory");
        }
    }
    __syncthreads();
}

struct Args { const float* in[24]; float* out; unsigned char* ws; int ph_lo, ph_hi; };
struct Frame {
    LAS unsigned char* lds; unsigned char* lds_gen; volatile LAS unsigned* MISC; unsigned* ctl;
    int tid, lane, wave, G, vcu;
    unsigned char* ws; float* X;
};
__device__ __forceinline__ void p0_item(const float* W, int ldw, int c0, int k0, bf16* WT, int Kd, int drow, int drow2, const float* kscale, LAS float* scr, int lane) {
    const int nq = lane & 7, kr = lane >> 3; f32x4 v[2][8];
#pragma unroll
    for (int hf = 0; hf < 2; ++hf)
#pragma unroll
        for (int i = 0; i < 8; ++i) v[hf][i] = *(const f32x4*)(W + (size_t)(k0 + kr + 8 * i) * ldw + c0 + 32 * hf + 4 * nq);
    if (kscale) {
#pragma unroll
        for (int i = 0; i < 8; ++i) { const float sc = kscale[k0 + kr + 8 * i]; v[0][i] = v[0][i] * sc; v[1][i] = v[1][i] * sc; } }
    const int c = lane & 7;
#pragma unroll
    for (int hf = 0; hf < 2; ++hf) {
#pragma unroll
        for (int i = 0; i < 8; ++i)
#pragma unroll
            for (int e = 0; e < 4; ++e) scr[(kr + 8 * i) * 33 + 4 * nq + e] = v[hf][i][e];
        LDS_WAIT(); asm volatile("" ::: "memory");
        const int dr = hf ? drow2 : drow;
#pragma unroll
        for (int j = 0; j < 4; ++j) { const int n = (lane >> 3) + 8 * j; const LAS float* s = scr + (8 * c) * 33 + n;
            v4u o; o.x = pk2(s[0 * 33], s[1 * 33]); o.y = pk2(s[2 * 33], s[3 * 33]); o.z = pk2(s[4 * 33], s[5 * 33]); o.w = pk2(s[6 * 33], s[7 * 33]);
            *(v4u*)(WT + (size_t)(dr + n) * Kd + k0 + 8 * c) = o; }
        LDS_WAIT(); asm volatile("" ::: "memory");
    }
}
constexpr int PTAB_OFF = LDSCTL_OFF + 1024;
struct Ptrs {
    volatile LAS unsigned* tab; unsigned char* ws;
    __device__ __forceinline__ const float* in(int i) const { const unsigned lo = __builtin_amdgcn_readfirstlane(tab[2 * i]), hi = __builtin_amdgcn_readfirstlane(tab[2 * i + 1]); return (const float*)(const GAS float*)(((unsigned long long)hi << 32) | lo); }
    __device__ __forceinline__ const float* x() const { return in(0); }
    __device__ __forceinline__ const float* ln_in_g() const { return in(1); }
    __device__ __forceinline__ const float* ln_in_b() const { return in(2); }
    __device__ __forceinline__ const float* w_in() const { return in(3); }
    __device__ __forceinline__ const float* b_f() const { return in(4); }
    __device__ __forceinline__ const float* conv_w() const { return in(5); }
    __device__ __forceinline__ const float* conv_b() const { return in(6); }
    __device__ __forceinline__ const float* sgu_ln_g() const { return in(7); }
    __device__ __forceinline__ const float* sgu_ln_b() const { return in(8); }
    __device__ __forceinline__ const float* sgu_w() const { return in(9); }
    __device__ __forceinline__ const float* sgu_b() const { return in(10); }
    __device__ __forceinline__ const float* grp_g() const { return in(11); }
    __device__ __forceinline__ const float* w_out() const { return in(12); }
    __device__ __forceinline__ const float* ln1_g() const { return in(13); }
    __device__ __forceinline__ const float* ln1_b() const { return in(14); }
    __device__ __forceinline__ const float* rgw() const { return in(15); }
    __device__ __forceinline__ const float* rgb() const { return in(16); }
    __device__ __forceinline__ const float* rew() const { return in(17); }
    __device__ __forceinline__ const float* reb() const { return in(18); }
    __device__ __forceinline__ const float* w1() const { return in(19); }
    __device__ __forceinline__ const float* w3() const { return in(20); }
    __device__ __forceinline__ const float* w2() const { return in(21); }
    __device__ __forceinline__ const float* ln2_g() const { return in(22); }
    __device__ __forceinline__ const float* ln2_b() const { return in(23); }
    __device__ __forceinline__ float* LF() const { return (float*)(ws + WS_LF); }
    __device__ __forceinline__ float* C2G() const { return (float*)(ws + WS_C2); }
    __device__ __forceinline__ float* GL() const { return (float*)(ws + WS_GL); }
    __device__ __forceinline__ float* SS() const { return (float*)(ws + WS_SS); }
    __device__ __forceinline__ float* TG() const { return (float*)(ws + WS_TG); }
    __device__ __forceinline__ int* TE() const { return (int*)(ws + WS_TE); }
    __device__ __forceinline__ int* TS() const { return (int*)(ws + WS_TS); }
    __device__ __forceinline__ int* RT() const { return (int*)(ws + WS_RT); }
    __device__ __forceinline__ bf16* RW() const { return (bf16*)(ws + WS_RW); }
    __device__ __forceinline__ bf16* SGW() const { return (bf16*)(ws + WS_SGW); }
    __device__ __forceinline__ bf16* WIN() const { return (bf16*)(ws + WS_WIN); }
    __device__ __forceinline__ bf16* WOUT() const { return (bf16*)(ws + WS_WOUT); }
    __device__ __forceinline__ bf16* W13() const { return (bf16*)(ws + WS_W13); }
    __device__ __forceinline__ bf16* W2() const { return (bf16*)(ws + WS_W2); }
    __device__ __forceinline__ bf16* XN() const { return (bf16*)(ws + WS_XN); }
    __device__ __forceinline__ bf16* MIX() const { return (bf16*)(ws + WS_MIX); }
    __device__ __forceinline__ bf16* PROJ() const { return (bf16*)(ws + WS_PROJ); }
    __device__ __forceinline__ bf16* MOUT() const { return (bf16*)(ws + WS_PROJ); }
    __device__ __forceinline__ bf16* O() const { return (bf16*)(ws + WS_PROJ); }
    __device__ __forceinline__ bf16* H() const { return (bf16*)(ws + WS_H); }
};
__device__ __forceinline__ int win_src_col(int n0) {
    if (n0 < 1536) return n0;
    if (n0 >= 2304) return n0 + 4;
    const int t = n0 - 1536, tile = t >> 8, off = t & 255;
    if (tile == 2) return 1540 + 256 + off;
    return (off < 128) ? 1540 + 128 * tile + off : 1540 + 512 + 128 * tile + (off - 128);
}
__device__ __forceinline__ void p0_weights(Frame& F, const Ptrs& P) {
    LAS float* scr = (LAS float*)(F.lds + F.wave * 16384);
    const int gw = F.vcu * 8 + F.wave, NGW = F.G * 8;
    constexpr int I_IN = 16 * 44, I_OUT = 16 * 16, PER_L = I_IN + I_OUT;
    for (int it = gw; it < NL * PER_L; it += NGW) {
        const int l = it / PER_L; int r = it % PER_L;
        if (r < I_IN) { const int kb = r / 44, nb = r % 44, n0 = 64 * nb; p0_item(P.w_in() + (size_t)l * D * PWIN, PWIN, win_src_col(n0), 64 * kb, P.WIN() + (size_t)l * NPROJ * D, D, n0, n0 + 32, nullptr, scr, F.lane); continue; } r -= I_IN;
        { const int kb = r / 16, nb = r % 16; p0_item(P.w_out() + (size_t)l * D * D, D, 64 * nb, 64 * kb, P.WOUT() + (size_t)l * D * D, D, 64 * nb, 64 * nb + 32, P.grp_g() + l * D, scr, F.lane); }
    }
    const int gt = F.vcu * 512 + F.tid, NGT = F.G * 512;
    for (int i = gt; i < NL * 64 * D; i += NGT) { const int l = i / (64 * D), row = (i / D) % 64, k = i % D;
        float v = 0.f; if (row < 32) v = P.rew()[((size_t)l * D + k) * 32 + row]; else if (row < 36) v = P.rgw()[((size_t)l * D + k) * 4 + (row - 32)];
        const unsigned hi = f2bf(v); const float lo = v - bf2f(hi);
        P.RW()[((size_t)(l * 2 + 0) * 64 + row) * D + k] = (bf16)hi; P.RW()[((size_t)(l * 2 + 1) * 64 + row) * D + k] = (bf16)f2bf(lo); }
    for (int i = gt; i < NL * NH * 128 * 128; i += NGT) { const int ii = (i >> 7) & 127, j = i & 127; const float v = ((j >> 6) <= (ii >> 6)) ? P.sgu_w()[i] : 0.f; P.SGW()[i] = (bf16)f2bf(v); }
}

struct WfRegs { f32x4 w[4][4]; };
__device__ __forceinline__ void load_wf(WfRegs& R, const float* w_in_l, int lane, int ld = PWIN, int col = 1536) {
#pragma unroll
    for (int j = 0; j < 4; ++j)
#pragma unroll
        for (int i = 0; i < 4; ++i) R.w[j][i] = *(const f32x4*)(w_in_l + (size_t)(4 * lane + 256 * j + i) * ld + col);
}
__device__ __forceinline__ void load_gb(f32x4 (&gr)[4], f32x4 (&br)[4], const float* g, const float* b, int lane) {
#pragma unroll
    for (int j = 0; j < 4; ++j) { gr[j] = *(const f32x4*)(g + 4 * lane + 256 * j); br[j] = *(const f32x4*)(b + 4 * lane + 256 * j); }
}
template <int LFL, bool WF32, bool WBF = true>
__device__ __forceinline__ void finish_row(f32x4 (&v)[4], const f32x4 (&gr)[4], const f32x4 (&br)[4], float* xrow, bf16* xnrow, const WfRegs& R, const f32x4 bf, float* lfrow, int lane) {
    float s = 0.f;
#pragma unroll
    for (int j = 0; j < 4; ++j) s += (v[j].x + v[j].y) + (v[j].z + v[j].w);
    const float mean = wave_sum(s) * (1.f / D); float s2 = 0.f;
#pragma unroll
    for (int j = 0; j < 4; ++j) { v[j] = v[j] - mean; s2 += (v[j].x * v[j].x + v[j].y * v[j].y) + (v[j].z * v[j].z + v[j].w * v[j].w); }
    const float rstd = rsqrtf(wave_sum(s2) * (1.f / D) + LN_EPS);
    f32x4 dots = {0.f, 0.f, 0.f, 0.f};
#pragma unroll
    for (int j = 0; j < 4; ++j) {
        const f32x4 y = v[j] * rstd * gr[j] + br[j];
        if (WF32) *(f32x4*)(xrow + 4 * lane + 256 * j) = y;
        if (WBF) { v2u o; o.x = pk2(y.x, y.y); o.y = pk2(y.z, y.w); *(v2u*)(xnrow + 4 * lane + 256 * j) = o; }
        if (LFL) dots = dots + R.w[j][0] * y.x + R.w[j][1] * y.y + R.w[j][2] * y.z + R.w[j][3] * y.w; }
    if (LFL) {
        const float d0 = wave_sum(dots.x), d1 = wave_sum(dots.y), d2 = wave_sum(dots.z), d3 = wave_sum(dots.w);
        if (lane == 0) { f32x4 o; if (LFL == 1) { o.x = log_sigmoid_f(d0 + bf[0]); o.y = log_sigmoid_f(d1 + bf[1]); o.z = log_sigmoid_f(d2 + bf[2]); o.w = log_sigmoid_f(d3 + bf[3]); } else { o.x = d0 + bf[0]; o.y = d1 + bf[1]; o.z = d2 + bf[2]; o.w = d3 + bf[3]; } *(f32x4*)lfrow = o; }
    }
}
__device__ __forceinline__ void p0_rows(Frame& F, const Ptrs& P) {
    WfRegs R; load_wf(R, P.w_in(), F.lane);
    const int gw = F.vcu * 8 + F.wave, NGW = F.G * 8;
    const float* x = P.x(); const f32x4 bf = *(const f32x4*)P.b_f(); bf16* XN = P.XN(); float* LF = P.LF();
    f32x4 lg[4], lb[4]; load_gb(lg, lb, P.ln_in_g(), P.ln_in_b(), F.lane);
    f32x4 cur[4], nxt[4];
    if (gw < T) {
#pragma unroll
        for (int j = 0; j < 4; ++j) cur[j] = *(const f32x4*)(x + (size_t)gw * D + 4 * F.lane + 256 * j); }
    for (int m = gw; m < T; m += NGW) {
        const int mn = m + NGW;
        if (mn < T) {
#pragma unroll
            for (int j = 0; j < 4; ++j) nxt[j] = *(const f32x4*)(x + (size_t)mn * D + 4 * F.lane + 256 * j); }
        finish_row<1, false>(cur, lg, lb, nullptr, XN + (size_t)m * D, R, bf, LF + (size_t)m * 4, F.lane);
#pragma unroll
        for (int j = 0; j < 4; ++j) cur[j] = nxt[j];
    }
}
__device__ __forceinline__ void c2_scan(Frame& F, const Ptrs& P, int bh) {
    const int tid = F.tid, lane = F.lane, w = F.wave; LAS float* red = (LAS float*)(F.lds);
    const size_t row0 = (size_t)(bh >> 2) * S; const int h = bh & 3;
    float a[4];
#pragma unroll
    for (int i = 0; i < 4; ++i) a[i] = P.LF()[(row0 + 4 * tid + i) * 4 + h] * LOG2E;
    a[1] += a[0]; a[2] += a[1]; a[3] += a[2];
    float run = a[3];
#pragma unroll
    for (int o = 1; o < 64; o <<= 1) { const float t = __shfl_up(run, o); if (lane >= o) run += t; }
    if (lane == 63) red[w] = run;
    __syncthreads();
    float base = run - a[3];
    for (int i = 0; i < w; ++i) base += red[i];
    f32x4 o; o.x = base + a[0]; o.y = base + a[1]; o.z = base + a[2]; o.w = base + a[3];
    *(f32x4*)(P.C2G() + (size_t)bh * S + 4 * tid) = o;
    __syncthreads();
}

typedef short v4i16_t __attribute__((ext_vector_type(4)));
__device__ __forceinline__ s16x4 vtr(const LAS unsigned char* p) { return __builtin_bit_cast(s16x4, __builtin_amdgcn_ds_read_tr16_b64_v4i16((LAS v4i16_t*)p)); }
__device__ __forceinline__ int crow(int r, int hi) { return (r & 3) + 8 * (r >> 2) + 4 * hi; }
__device__ __forceinline__ bf16x8 pack8(const f32x16& p, int b0) {
    v4u w; w.x = pk2(p[b0], p[b0 + 1]); w.y = pk2(p[b0 + 2], p[b0 + 3]); w.z = pk2(p[b0 + 4], p[b0 + 5]); w.w = pk2(p[b0 + 6], p[b0 + 7]); return __builtin_bit_cast(bf16x8, w);
}
constexpr int AT_K = 0, AT_V = 16384, AT_C = 32768, AT_RED = 40960;

template <bool STICK, bool DIAG, int MODE = 0>
__device__ __forceinline__ void attn_tile(const LAS unsigned char* Kb, const LAS unsigned char* Vb, const int (&kra)[4], const int vp0, const bf16x8 (&qr)[4],
                                          const LAS float* CBt, f32x16& cbase, const int qrel_, const int hh, f32x16 (&o)[2], float& m_run, float& l_run, float& Rp) {
    if (MODE == 3) return;
    int qrel = qrel_; if (DIAG) asm volatile("" : "+v"(qrel));
    bf16x8 kf[2][4];
#pragma unroll
    for (int kb = 0; kb < 2; ++kb)
#pragma unroll
        for (int ks = 0; ks < 4; ++ks) kf[kb][ks] = (MODE == 4) ? qr[(ks + kb) & 3] : *(const LAS bf16x8*)(Kb + kra[ks] + kb * 4096);
    f32x16 sc[2];
#pragma unroll
    for (int kb = 0; kb < 2; ++kb) { f32x16 a = STICK ? f32x16{} : cbase;
#pragma unroll
        for (int ks = 0; ks < 4; ++ks) a = __builtin_amdgcn_mfma_f32_32x32x16_bf16(kf[kb][ks], qr[ks], a, 0, 0, 0);
        sc[kb] = a; }
    s16x4 vlo[4], vhi[4];
#pragma unroll
    for (int ks = 0; ks < 4; ++ks) { if (MODE == 5) { vlo[ks] = __builtin_bit_cast(s16x4, (v2u){(unsigned)qr[ks][0], (unsigned)qr[ks][1]}); vhi[ks] = vlo[ks]; } else { vlo[ks] = vtr(Vb + vp0 + ks * 1024); vhi[ks] = vtr(Vb + vp0 + ks * 1024 + 512); } }
    if (MODE == 1) {
#pragma unroll
        for (int i = 0; i < 16; ++i) { sc[0][i] *= 0.001f; sc[1][i] *= 0.001f; }
    } else if (!STICK) {
#pragma unroll
        for (int kb = 0; kb < 2; ++kb)
#pragma unroll
            for (int g4 = 0; g4 < 4; ++g4) { const f32x4 ncs = *(const LAS f32x4*)(CBt + 32 * kb + 8 * g4 + 4 * hh);
                f32x2 a = {sc[kb][4 * g4], sc[kb][4 * g4 + 1]}, c = {sc[kb][4 * g4 + 2], sc[kb][4 * g4 + 3]};
                a = a + (f32x2){ncs.x, ncs.y}; c = c + (f32x2){ncs.z, ncs.w};
                sc[kb][4 * g4] = a.x; sc[kb][4 * g4 + 1] = a.y; sc[kb][4 * g4 + 2] = c.x; sc[kb][4 * g4 + 3] = c.y;
                if (DIAG) {
#pragma unroll
                    for (int e = 0; e < 4; ++e) sc[kb][4 * g4 + e] = (32 * kb + 8 * g4 + 4 * hh + e > qrel) ? -1e30f : sc[kb][4 * g4 + e]; } }
        float m0 = fmaxf(fmaxf(sc[0][0], sc[0][1]), sc[0][2]), m1 = fmaxf(fmaxf(sc[1][0], sc[1][1]), sc[1][2]);
#pragma unroll
        for (int i = 3; i < 15; i += 2) { m0 = fmaxf(fmaxf(m0, sc[0][i]), sc[0][i + 1]); m1 = fmaxf(fmaxf(m1, sc[1][i]), sc[1][i + 1]); }
        float mx = fmaxf(fmaxf(m0, m1), fmaxf(sc[0][15], sc[1][15]));
        mx = fmaxf(mx, other_half(mx));
        if (__any(mx > 0.f)) {
            const float dl = fmaxf(mx, 0.f), alpha = __builtin_amdgcn_exp2f(-dl); m_run += dl; l_run *= alpha;
#pragma unroll
            for (int i = 0; i < 16; ++i) { o[0][i] *= alpha; o[1][i] *= alpha; sc[0][i] -= dl; sc[1][i] -= dl; cbase[i] -= dl; }
        }
        f32x2 ps2 = {0.f, 0.f};
#pragma unroll
        for (int kb = 0; kb < 2; ++kb)
#pragma unroll
            for (int i = 0; i < 16; i += 2) { f32x2 p = {__builtin_amdgcn_exp2f(sc[kb][i]), __builtin_amdgcn_exp2f(sc[kb][i + 1])}; sc[kb][i] = p.x; sc[kb][i + 1] = p.y; ps2 = ps2 + p; }
        l_run += ps2.x + ps2.y;
    } else {
#pragma unroll
        for (int kb = 1; kb >= 0; --kb) {
            float om[16], be[16];
#pragma unroll
            for (int i = 0; i < 16; ++i) { const float e = __builtin_amdgcn_exp2f(sc[kb][i]); float t = __builtin_amdgcn_rcpf(1.0f + e);
                if (DIAG) t = (32 * kb + crow(i, 0) + 4 * hh >= qrel) ? 1.0f : t;
                om[i] = t; be[i] = 1.0f - t; }
            float se[16], gp[4], pr[4], og[4];
#pragma unroll
            for (int g4 = 0; g4 < 4; ++g4) { se[4 * g4 + 3] = 1.0f; se[4 * g4 + 2] = om[4 * g4 + 3]; se[4 * g4 + 1] = se[4 * g4 + 2] * om[4 * g4 + 2]; se[4 * g4] = se[4 * g4 + 1] * om[4 * g4 + 1]; gp[g4] = se[4 * g4] * om[4 * g4];
                og[g4] = other_half(gp[g4]); pr[g4] = gp[g4] * og[g4]; }
            float later = Rp;
#pragma unroll
            for (int g4 = 3; g4 >= 0; --g4) { const float fac = later * (hh ? 1.0f : og[g4]);
#pragma unroll
                for (int e = 0; e < 4; ++e) sc[kb][4 * g4 + e] = be[4 * g4 + e] * se[4 * g4 + e] * fac;
                later *= pr[g4]; }
            Rp = later;
        }
    }
    bf16x8 pf[4]; pf[0] = pack8(sc[0], 0); pf[1] = pack8(sc[0], 8); pf[2] = pack8(sc[1], 0); pf[3] = pack8(sc[1], 8);
    if (MODE == 2) { o[0][0] += __builtin_bit_cast(v4u, pf[0]).x + __builtin_bit_cast(v4u, pf[1]).x + __builtin_bit_cast(v4u, pf[2]).x + __builtin_bit_cast(v4u, pf[3]).x + vlo[0][0] + vhi[3][0]; return; }
    s16x4 wlo[4], whi[4];
#pragma unroll
    for (int ks = 0; ks < 4; ++ks) { if (MODE == 5) { wlo[ks] = vlo[ks]; whi[ks] = vhi[ks]; } else { wlo[ks] = vtr(Vb + vp0 + 4096 + ks * 1024); whi[ks] = vtr(Vb + vp0 + 4096 + ks * 1024 + 512); } }
#pragma unroll
    for (int ks = 0; ks < 4; ++ks) { const bf16x8 vf = (bf16x8){vlo[ks][0], vlo[ks][1], vlo[ks][2], vlo[ks][3], vhi[ks][0], vhi[ks][1], vhi[ks][2], vhi[ks][3]};
        o[0] = __builtin_amdgcn_mfma_f32_32x32x16_bf16(vf, pf[ks], o[0], 0, 0, 0); }
#pragma unroll
    for (int ks = 0; ks < 4; ++ks) { const bf16x8 vf = (bf16x8){wlo[ks][0], wlo[ks][1], wlo[ks][2], wlo[ks][3], whi[ks][0], whi[ks][1], whi[ks][2], whi[ks][3]};
        o[1] = __builtin_amdgcn_mfma_f32_32x32x16_bf16(vf, pf[ks], o[1], 0, 0, 0); }
}

constexpr int AT_CB = LDSCTL_OFF + 4096;
template <bool STICK, int MODE = 0>
__device__ __forceinline__ void attn_unit(Frame& F, const Ptrs& P, int layer, int b, int h, int qb) {
    const int tid = F.tid, lane = F.lane, w = F.wave, r = lane & 31, hh = lane >> 5;
    const int qcol = (STICK ? 0 : 768) + h * HD, kcol = qcol + 256, vcol = qcol + 512, ocol = (STICK ? 0 : 256) + h * HD;
    const size_t row0 = (size_t)b * S;
    LAS unsigned char* lds = F.lds;
    const int skrow = 8 * w + (lane >> 3);
    const bf16* ksrc = P.PROJ() + (row0 + skrow) * NPROJ + kcol + 8 * ((lane & 7) ^ ((skrow >> 1) & 7));
    const bf16* vsrc = P.PROJ() + (row0 + 16 * (w & 3) + (lane >> 2)) * NPROJ + vcol + 32 * ((w >> 2) & 1) + 8 * (lane & 3);
#define ATT_STAGE(c_, bsel_) do { const size_t co_ = (size_t)(c_) * 256 * NPROJ; _Pragma("unroll") for (int j_ = 0; j_ < 4; ++j_) { \
        __builtin_amdgcn_global_load_lds((const unsigned*)(ksrc + co_ + (size_t)j_ * 64 * NPROJ), (LAS unsigned*)(lds + (bsel_) * 65536 + (64 * j_ + 8 * w) * 128), 16, 0, 0); \
        __builtin_amdgcn_global_load_lds((const unsigned*)(vsrc + co_ + (size_t)j_ * 64 * NPROJ), (LAS unsigned*)(lds + (bsel_) * 65536 + 32768 + (8 * j_ + w) * 1024), 16, 0, 0); } } while (0)
    ATT_STAGE(qb, 0);
    __builtin_amdgcn_sched_barrier(0);
    LAS float* CB = (LAS float*)(lds + AT_CB);
    if (!STICK) { if (tid < 64 * (qb + 1)) *(LAS f32x4*)(CB + 4 * tid) = -*(const f32x4*)(P.C2G() + (size_t)(b * NH + h) * S + 4 * tid); }
    const int qrow = 256 * qb + 32 * w + r;
    bf16x8 qr[4];
#pragma unroll
    for (int ks = 0; ks < 4; ++ks) qr[ks] = *(const bf16x8*)(P.PROJ() + (row0 + qrow) * NPROJ + qcol + 16 * ks + 8 * hh);
    const int my_hi = 4 * qb + (w >> 1), qrel = 32 * (w & 1) + r;
    float zb = 0.f;
    if (!STICK) { float s2 = 0.f;
#pragma unroll
        for (int ks = 0; ks < 4; ++ks) { const v4u qq = __builtin_bit_cast(v4u, qr[ks]);
            s2 += (bflo(qq.x) * bflo(qq.x) + bfhi(qq.x) * bfhi(qq.x)) + (bflo(qq.y) * bflo(qq.y) + bfhi(qq.y) * bfhi(qq.y)) + (bflo(qq.z) * bflo(qq.z) + bfhi(qq.z) * bfhi(qq.z)) + (bflo(qq.w) * bflo(qq.w) + bfhi(qq.w) * bfhi(qq.w)); }
        s2 += other_half(s2);
        const unsigned* kw = F.ctl + CW_KINF + 128 * layer + (b * 4 + h) * 2;
        const float k2 = __uint_as_float(__hip_atomic_load(kw, RLX_AGENT)) + __uint_as_float(__hip_atomic_load(kw + 1, RLX_AGENT));
        zb = sqrtf(s2 * k2) * 1.01f; }
    const int vp0 = ((lane >> 4) & 1) * 32 + (lane & 3) * 8 + (4 * hh + ((lane & 15) >> 2)) * 64;
    int kra[4];
#pragma unroll
    for (int ks = 0; ks < 4; ++ks) kra[ks] = r * 128 + (((2 * ks + hh) ^ ((r >> 1) & 7)) * 16);
    f32x16 o[2]; o[0] = f32x16{}; o[1] = f32x16{};
    float m_run = 0.f, l_run = 0.f, Rp = 1.0f, ct2 = 0.f;
    asm volatile("s_waitcnt vmcnt(0)" ::: "memory");
    __syncthreads();
    if (!STICK) ct2 = -CB[qrow];
    f32x16 cbase;
#pragma unroll
    for (int i = 0; i < 16; ++i) cbase[i] = ct2;
    int buf = 0; bool wdone = false;
    for (int c = qb; c >= 0; --c) {
        if (c > 0) ATT_STAGE(c - 1, buf ^ 1);
#pragma nounroll
        for (int t4 = 3; t4 >= 0; --t4) { const int kt = 4 * c + t4;
            if (kt <= my_hi && !wdone) { const LAS unsigned char* Kb = lds + buf * 65536 + t4 * 8192; const LAS unsigned char* Vb = Kb + 32768;
                if (kt == my_hi) attn_tile<STICK, true, MODE>(Kb, Vb, kra, vp0, qr, CB + 64 * kt, cbase, qrel, hh, o, m_run, l_run, Rp);
                else attn_tile<STICK, false, MODE>(Kb, Vb, kra, vp0, qr, CB + 64 * kt, cbase, qrel, hh, o, m_run, l_run, Rp);
                wdone = STICK ? __all(Rp < 1e-14f) : (kt > 0 && __all(zb + ct2 + CB[64 * kt - 1] - m_run < -48.f)); } }
        if (lane == 0) F.MISC[16 + 8 * (c & 1) + w] = wdone ? 1u : 0u;
        asm volatile("s_waitcnt vmcnt(0)" ::: "memory");
        __syncthreads();
        buf ^= 1;
        unsigned all_ = 1u;
#pragma unroll
        for (int i_ = 0; i_ < 8; ++i_) all_ &= F.MISC[16 + 8 * (c & 1) + i_];
        if (all_) break;
    }
#undef ATT_STAGE
    float inv = 1.0f;
    if (!STICK) { const float lt = l_run + other_half(l_run); inv = 1.0f / lt; }
    float ss = 0.f;
#pragma unroll
    for (int dh = 0; dh < 2; ++dh)
#pragma unroll
        for (int i = 0; i < 16; ++i) { o[dh][i] *= inv; ss += o[dh][i] * o[dh][i]; }
    ss += other_half(ss);
    const size_t tok = row0 + qrow;
    if (hh == 0) P.SS()[tok * 8 + (STICK ? 0 : 4) + h] = ss;
    LAS unsigned char* stg = lds + w * 4608;
#pragma unroll
    for (int dh = 0; dh < 2; ++dh)
#pragma unroll
        for (int g4 = 0; g4 < 4; ++g4) { v2u ov; ov.x = pk2(o[dh][4 * g4], o[dh][4 * g4 + 1]); ov.y = pk2(o[dh][4 * g4 + 2], o[dh][4 * g4 + 3]); *(LAS v2u*)(stg + r * 144 + (32 * dh + 8 * g4 + 4 * hh) * 2) = ov; }
    LDS_WAIT();
    bf16* ob = P.MIX() + (row0 + 256 * qb + 32 * w) * D + ocol;
#pragma unroll
    for (int i = 0; i < 4; ++i) { const int row = 8 * i + (lane >> 3), ch = lane & 7; const v4u v = *(const LAS v4u*)(stg + row * 144 + ch * 16); *(v4u*)(ob + (size_t)row * D + 8 * ch) = v; }
}

__device__ __forceinline__ f32x4 ld4bf(const bf16* p) { const v2u q = *(const v2u*)p; return (f32x4){bflo(q.x), bfhi(q.x), bflo(q.y), bfhi(q.y)}; }
#define UNP(q) ((f32x4){bflo((q).x), bfhi((q).x), bflo((q).y), bfhi((q).y)})
__device__ __forceinline__ void conv_unit(Frame& F, const Ptrs& P, int layer, int cu) {
    const int lane = F.lane, c = 4 * lane;
    const float* cw = P.conv_w() + (size_t)layer * 3 * GW; const f32x4 w0 = *(const f32x4*)(cw + c), w1 = *(const f32x4*)(cw + GW + c), w2 = *(const f32x4*)(cw + 2 * GW + c), cb = *(const f32x4*)(P.conv_b() + (size_t)layer * GW + c);
    const int tok0 = cu * 128 + F.wave * 16, t0 = tok0 % S;
    const char* ub = (const char*)(P.PROJ() + (size_t)tok0 * NPROJ); char* mb = (char*)(P.MIX() + (size_t)tok0 * D + 512); const unsigned lo = 8u * (unsigned)lane;
#define CLD(i, col) (*(const v2u*)(ub + (ptrdiff_t)(i) * (NPROJ * 2) + (col) * 2 + lo))
    f32x4 z2 = {0.f, 0.f, 0.f, 0.f}, z1 = {0.f, 0.f, 0.f, 0.f};
    if (t0 >= 2) { z2 = UNP(CLD(-2, 1536)); z1 = UNP(CLD(-1, 1536)); }
#pragma unroll
    for (int hf = 0; hf < 2; ++hf) {
        v2u zq[8], bq[8];
#pragma unroll
        for (int i = 0; i < 8; ++i) { zq[i] = CLD(8 * hf + i, 1536); bq[i] = CLD(8 * hf + i, 2048); }
#pragma unroll
        for (int i = 0; i < 8; ++i) {
            const f32x4 z0 = UNP(zq[i]), bg = UNP(bq[i]);
            const f32x4 y = bg * (cb + w0 * z2 + w1 * z1 + w2 * z0);
            const float q = wave_sum((y.x * y.x + y.y * y.y) + (y.z * y.z + y.w * y.w));
            const float rs = rsqrtf(q * (1.f / GW) + RMS_EPS);
            v2u o; o.x = pk2(y.x * rs, y.y * rs); o.y = pk2(y.z * rs, y.w * rs); *(v2u*)(mb + (size_t)(8 * hf + i) * (D * 2) + lo) = o;
            z2 = z1; z1 = z0; }
    }
#undef CLD
}

constexpr int SG_VL = 0, SG_SSQ = 65536;
template <int MODE = 0>
__device__ __forceinline__ void sgu_unit(Frame& F, const Ptrs& P, int layer, int su) {
    const int lane = F.lane, w = F.wave, r = lane & 31, hh = lane >> 5;
    const size_t base = (size_t)su * 128;
    LAS unsigned char* lds = F.lds;
    const int g = w >> 1, ih = w & 1;
    const bf16* wg0 = P.SGW() + ((size_t)(layer * NH + g) * 128 + 64 * ih + r) * 128 + 4 * hh; const bf16* wg1 = wg0 + 32 * 128;
    asm volatile("" : "+v"(wg0), "+v"(wg1));
    v2u wq[8][2][2];
    {
        const int c = 4 * lane; const f32x4 gg = *(const f32x4*)(P.sgu_ln_g() + (size_t)layer * GW + c), bb = *(const f32x4*)(P.sgu_ln_b() + (size_t)layer * GW + c);
        const bf16* vp = P.PROJ() + (base + 16 * w) * NPROJ + 2560 + c; v2u vq[16];
#pragma unroll
        for (int i = 0; i < 16; ++i) vq[i] = *(const v2u*)(vp + (size_t)i * NPROJ);
#pragma unroll
    for (int ks = 0; ks < 8; ++ks) { wq[ks][0][0] = *(const v2u*)(wg0 + 16 * ks); wq[ks][0][1] = *(const v2u*)(wg0 + 16 * ks + 8); wq[ks][1][0] = *(const v2u*)(wg1 + 16 * ks); wq[ks][1][1] = *(const v2u*)(wg1 + 16 * ks + 8); }
    __builtin_amdgcn_sched_barrier(0);
#pragma unroll
        for (int i = 0; i < 16; ++i) { const int j = 16 * w + i; f32x4 v = UNP(vq[i]);
            if (MODE == 12) { v2u o; o.x = pk2(v.x, v.y); o.y = pk2(v.z, v.w); *(LAS v2u*)(lds + SG_VL + (c >> 5) * 8192 + (j >> 4) * 1024 + (j & 15) * 64 + (c & 31) * 2) = o; continue; }
            const float mean = wave_sum((v.x + v.y) + (v.z + v.w)) * (1.f / GW); v = v - mean;
            const float rstd = rsqrtf(wave_sum((v.x * v.x + v.y * v.y) + (v.z * v.z + v.w * v.w)) * (1.f / GW) + LN_EPS);
            v = v * rstd * gg + bb; v2u o; o.x = pk2(v.x, v.y); o.y = pk2(v.z, v.w);
            *(LAS v2u*)(lds + SG_VL + (c >> 5) * 8192 + (j >> 4) * 1024 + (j & 15) * 64 + (c & 31) * 2) = o; }
    }
    __syncthreads();
    f32x16 acc[2][2]; acc[0][0] = f32x16{}; acc[0][1] = f32x16{}; acc[1][0] = f32x16{}; acc[1][1] = f32x16{};
    const int vp0 = ((lane >> 4) & 1) * 32 + (lane & 3) * 8 + (4 * hh + ((lane & 15) >> 2)) * 64;
    v2u uq[2][2][4];
#pragma unroll
    for (int ib = 0; ib < 2; ++ib)
#pragma unroll
        for (int cb = 0; cb < 2; ++cb)
#pragma unroll
            for (int g4 = 0; g4 < 4; ++g4) uq[ib][cb][g4] = *(const v2u*)(P.PROJ() + (base + 64 * ih + 32 * ib + r) * NPROJ + 2304 + 64 * g + 32 * cb + 8 * g4 + 4 * hh);
    __builtin_amdgcn_sched_barrier(0);
#pragma unroll
    for (int ks = 0; ks < (MODE == 11 ? 0 : 8); ++ks) {
        bf16x8 wf[2], vf[2];
#pragma unroll
        for (int ib = 0; ib < 2; ++ib) { v4u t; t.x = wq[ks][ib][0].x; t.y = wq[ks][ib][0].y; t.z = wq[ks][ib][1].x; t.w = wq[ks][ib][1].y; wf[ib] = __builtin_bit_cast(bf16x8, t); }
#pragma unroll
        for (int cb = 0; cb < 2; ++cb) { const LAS unsigned char* vb = lds + SG_VL + (2 * g + cb) * 8192 + ks * 1024 + vp0; const s16x4 lo = vtr(vb), hi = vtr(vb + 512);
            vf[cb] = (bf16x8){lo[0], lo[1], lo[2], lo[3], hi[0], hi[1], hi[2], hi[3]}; }
#pragma unroll
        for (int cb = 0; cb < 2; ++cb)
#pragma unroll
            for (int ib = 0; ib < 2; ++ib) acc[cb][ib] = __builtin_amdgcn_mfma_f32_32x32x16_bf16(vf[cb], wf[ib], acc[cb][ib], 0, 0, 0);
    }
    LAS float* SSQ = (LAS float*)(lds + SG_SSQ);
#pragma unroll
    for (int ib = 0; ib < 2; ++ib) { const int i = 64 * ih + 32 * ib + r; const float bs = P.sgu_b()[(size_t)(layer * NH + g) * 128 + i]; float q = 0.f;
#pragma unroll
        for (int cb = 0; cb < 2; ++cb)
#pragma unroll
            for (int g4 = 0; g4 < 4; ++g4) { const f32x4 uu = UNP(uq[ib][cb][g4]);
#pragma unroll
                for (int e = 0; e < 4; ++e) { const float t = uu[e] * (acc[cb][ib][4 * g4 + e] + bs); acc[cb][ib][4 * g4 + e] = t; q += t * t; } }
        q += other_half(q);
        if (hh == 0) SSQ[i * 4 + g] = q; }
    __syncthreads();
#pragma unroll
    for (int ib = 0; ib < 2; ++ib) { const int i = 64 * ih + 32 * ib + r; const f32x4 qq = *(const LAS f32x4*)(SSQ + i * 4);
        const float rs = rsqrtf(((qq.x + qq.y) + (qq.z + qq.w)) * (1.f / GW) + RMS_EPS);
#pragma unroll
        for (int cb = 0; cb < 2; ++cb)
#pragma unroll
            for (int g4 = 0; g4 < 4; ++g4) { v2u o; o.x = pk2(acc[cb][ib][4 * g4] * rs, acc[cb][ib][4 * g4 + 1] * rs); o.y = pk2(acc[cb][ib][4 * g4 + 2] * rs, acc[cb][ib][4 * g4 + 3] * rs);
                *(v2u*)(P.MIX() + (base + i) * D + 768 + 64 * g + 32 * cb + 8 * g4 + 4 * hh) = o; } }
    __syncthreads();
}
#undef UNP

constexpr int MOE_ITEMS = NE * 192;
__device__ __forceinline__ void moe_cvt_item(Frame& F, const Ptrs& P, int l, int it) {
    LAS float* scr = (LAS float*)(F.lds + F.wave * 16384);
    const int e = it / 192; int r = it % 192;
    if (r < 128) { const int which = r >> 6, q = r & 63, kb = q >> 2, nb = q & 3, j0 = 64 * nb, dr = 256 * (j0 >> 7) + 128 * which + (j0 & 127);
        p0_item((which ? P.w3() : P.w1()) + ((size_t)l * NE + e) * D * DE, DE, j0, 64 * kb, P.W13() + ((size_t)l * NE + e) * 512 * D, D, dr, dr + 32, nullptr, scr, F.lane); }
    else { r -= 128; const int kb = r >> 4, nb = r & 15; p0_item(P.w2() + ((size_t)l * NE + e) * DE * D, D, 64 * nb, 64 * kb, P.W2() + ((size_t)l * NE + e) * D * DE, DE, 64 * nb, 64 * nb + 32, nullptr, scr, F.lane); }
}
__device__ __forceinline__ void moe_cvt_tail(Frame& F, const Ptrs& P, int l, int part) {
    const int nwg = (T / 256) * (NPROJ / 256), rem = nwg % F.G, c = (int)blockIdx.x;
    int idx, stride;
    if (rem == 0) { idx = c * 8 + F.wave; stride = F.G * 8; } else { if (c < rem) return; idx = (c - rem) * 8 + F.wave; stride = (F.G - rem) * 8; }
    const int per = (MOE_ITEMS + stride - 1) / stride, half = per / 2;
    for (int k = part ? half : 0; k < (part ? per : half); ++k) { const int it = idx + k * stride; if (it < MOE_ITEMS) moe_cvt_item(F, P, l, it); }
    __syncthreads();
}

template <int MODE = 0>
__device__ __forceinline__ void mixer_phase(Frame& F, const Ptrs& P, int layer, int qslot, int u_lo = 0, int u_hi = 1 << 30) {
    constexpr int NU_ATT = NB * 8 * NH, NU = 2 * NU_ATT + NB * 16 + T / 128;
    unsigned* head = F.ctl + CW_QUEUE + 64 * qslot;
    unsigned nxt = 0u;
    if (F.tid == 0) nxt = __hip_atomic_fetch_add(head, 1u, RLX_AGENT);
    for (;;) {
        if (F.tid == 0) F.MISC[0] = nxt;
        __syncthreads();
        const int u = (int)F.MISC[0] + u_lo;
        if (u >= NU || u >= u_hi) break;
        if (F.tid == 0) nxt = __hip_atomic_fetch_add(head, 1u, RLX_AGENT);
        asm volatile("" : "+v"(F.tid)); F.lane = F.tid & 63;
        { int v = u;
            if (u >= NU_ATT && u < NU_ATT + NB * 16) v = 2 * NU_ATT + (u - NU_ATT); else if (u >= NU_ATT + NB * 16 && u < 2 * NU_ATT + NB * 16) v = u - NB * 16;
            if (v < NU_ATT) { const int qb = 7 - v / 64, bh = v % 64; attn_unit<false, MODE>(F, P, layer, bh >> 2, bh & 3, qb); }
            else if (v < 2 * NU_ATT) { const int v2 = v - NU_ATT, qb = 7 - v2 / 64, bh = v2 % 64; attn_unit<true, MODE>(F, P, layer, bh >> 2, bh & 3, qb); }
            else if (v < 2 * NU_ATT + NB * 16) sgu_unit<(MODE >= 10 ? MODE : 0)>(F, P, layer, v - 2 * NU_ATT);
            else conv_unit(F, P, layer, v - 2 * NU_ATT - NB * 16); }
        __syncthreads();
    }
}
__device__ __forceinline__ void norm_phase(Frame& F, const Ptrs& P) {
    const int gw = F.vcu * 8 + F.wave, NGW = F.G * 8, lane = F.lane;
    const float* SS = P.SS(); bf16* MIX = P.MIX();
    f32x4 q, qn; v4u v, vn;
    if (gw < T) { q = *(const f32x4*)(SS + (size_t)gw * 8 + 4 * (lane >> 5)); v = *(const v4u*)(MIX + (size_t)gw * D + 8 * lane); }
    for (int m = gw; m < T; m += NGW) {
        const int mn = m + NGW;
        if (mn < T) { qn = *(const f32x4*)(SS + (size_t)mn * 8 + 4 * (lane >> 5)); vn = *(const v4u*)(MIX + (size_t)mn * D + 8 * lane); }
        const float rs = rsqrtf(((q.x + q.y) + (q.z + q.w)) * (1.f / GW) + RMS_EPS);
        v.x = pk2(bflo(v.x) * rs, bfhi(v.x) * rs); v.y = pk2(bflo(v.y) * rs, bfhi(v.y) * rs); v.z = pk2(bflo(v.z) * rs, bfhi(v.z) * rs); v.w = pk2(bflo(v.w) * rs, bfhi(v.w) * rs);
        *(v4u*)(MIX + (size_t)m * D + 8 * lane) = v;
        q = qn; v = vn;
    }
}
constexpr int LC_PSTART = 0, LC_CNT = 33;
template <int MODE = 0>
__device__ __forceinline__ void router_phase(Frame& F, const Ptrs& P, int layer, int cslot) {
    const int lane = F.lane, w = F.wave, r = lane & 31, hh = lane >> 5;
    LAS int* lcnt = (LAS int*)(F.lds); LAS int* lbase = lcnt + 32; LAS float* red = (LAS float*)(F.lds + 4096);
    const bf16* RWh = P.RW() + (size_t)(layer * 2 + 0) * 64 * D; const bf16* RWl = P.RW() + (size_t)(layer * 2 + 1) * 64 * D;
    f32x4 g1[4], b1[4]; load_gb(g1, b1, P.ln1_g() + (size_t)layer * D, P.ln1_b() + (size_t)layer * D, lane); bf16* XN = P.XN();
    unsigned* gcnt = F.ctl + CW_CNT + 64 * cslot;
    WfRegs Rdummy;
    for (int ch = F.vcu; ch < T / 128; ch += F.G) {
        const int m0 = ch * 128;
        if (F.tid < 64) lcnt[F.tid] = 0;
        if (MODE != 2) {
            v2u cq[4], nq[4], cm[4], nm[4]; bf16* rb = XN + (size_t)(m0 + 16 * w) * D + 4 * lane; const bf16* mb = P.MOUT() + (size_t)(m0 + 16 * w) * D + 4 * lane;
#pragma unroll
            for (int j = 0; j < 4; ++j) { cq[j] = *(const v2u*)(rb + 256 * j); cm[j] = *(const v2u*)(mb + 256 * j); }
            for (int i = 0; i < 16; ++i) {
                if (i + 1 < 16) {
#pragma unroll
                    for (int j = 0; j < 4; ++j) { nq[j] = *(const v2u*)(rb + (size_t)(i + 1) * D + 256 * j); nm[j] = *(const v2u*)(mb + (size_t)(i + 1) * D + 256 * j); } }
                f32x4 cur[4];
#pragma unroll
                for (int j = 0; j < 4; ++j) cur[j] = (f32x4){ALPHA * bflo(cq[j].x) + bflo(cm[j].x), ALPHA * bfhi(cq[j].x) + bfhi(cm[j].x), ALPHA * bflo(cq[j].y) + bflo(cm[j].y), ALPHA * bfhi(cq[j].y) + bfhi(cm[j].y)};
                finish_row<0, false>(cur, g1, b1, nullptr, XN + (size_t)(m0 + 16 * w + i) * D, Rdummy, (f32x4){0.f, 0.f, 0.f, 0.f}, nullptr, lane);
#pragma unroll
                for (int j = 0; j < 4; ++j) { cq[j] = nq[j]; cm[j] = nm[j]; } }
        }
        VM_WAIT();
        __syncthreads();
        const int tok = m0 + 32 * (w & 3) + r;
        f32x16 a0 = f32x16{}, a1 = f32x16{};
        {
            const bf16* xr = XN + (size_t)tok * D + 512 * (w >> 2) + 8 * hh;
            const bf16* wh = RWh + (size_t)r * D + 512 * (w >> 2) + 8 * hh;
#pragma unroll 4
            for (int s = 0; s < (MODE == 1 ? 0 : 32); ++s) {
                const bf16x8 xv = *(const bf16x8*)(xr + 16 * s);
                const bf16x8 wh0 = *(const bf16x8*)(wh + 16 * s), wh1 = *(const bf16x8*)(wh + (size_t)32 * D + 16 * s);
                a0 = __builtin_amdgcn_mfma_f32_32x32x16_bf16(wh0, xv, a0, 0, 0, 0);
                a1 = __builtin_amdgcn_mfma_f32_32x32x16_bf16(wh1, xv, a1, 0, 0, 0);
            }
        }
        if (w >= 4) {
#pragma unroll
            for (int i = 0; i < 16; ++i) red[((w & 3) * 20 + i) * 64 + lane] = a0[i];
#pragma unroll
            for (int i = 0; i < 4; ++i) red[((w & 3) * 20 + 16 + i) * 64 + lane] = a1[i]; }
        __syncthreads();
        int e0 = 0, e1 = 0, rk0 = 0, rk1 = 0; float ga0 = 0.f, ga1 = 0.f;
        if (w < 4) {
#pragma unroll
            for (int i = 0; i < 16; ++i) a0[i] += red[(w * 20 + i) * 64 + lane];
#pragma unroll
            for (int i = 0; i < 4; ++i) a1[i] += red[(w * 20 + 16 + i) * 64 + lane];
            float lg[4];
#pragma unroll
            for (int i = 0; i < 4; ++i) { const float t = other_half(a1[i]); lg[i] = (hh ? t : a1[i]) + P.rgb()[layer * 4 + i]; }
            int gs = 0; float mx = lg[0];
#pragma unroll
            for (int i = 1; i < 4; ++i) if (lg[i] > mx) { mx = lg[i]; gs = i; }
            float den = 0.f;
#pragma unroll
            for (int i = 0; i < 4; ++i) den += __expf(lg[i] - mx);
            const float pg = 1.0f / den;
            float own[4], oth[4], v[8];
#pragma unroll
            for (int k = 0; k < 4; ++k) { float t = a0[k];
#pragma unroll
                for (int g = 1; g < 4; ++g) if (gs == g) t = a0[4 * g + k];
                own[k] = t; oth[k] = other_half(t); }
#pragma unroll
            for (int k = 0; k < 4; ++k) { v[k] = hh ? oth[k] : own[k]; v[4 + k] = hh ? own[k] : oth[k]; }
            float m2 = -1e30f;
#pragma unroll
            for (int k = 0; k < 8; ++k) { v[k] += P.reb()[layer * 32 + gs * 8 + k]; m2 = fmaxf(m2, v[k]); }
            float p[8], ds = 0.f;
#pragma unroll
            for (int k = 0; k < 8; ++k) { p[k] = __expf(v[k] - m2); ds += p[k]; }
            int i0 = 0; float p0 = -1.f;
#pragma unroll
            for (int k = 0; k < 8; ++k) { p[k] = p[k] / ds; if (p[k] > p0) { p0 = p[k]; i0 = k; } }
            int i1 = 0; float p1 = -1.f;
#pragma unroll
            for (int k = 0; k < 8; ++k) if (k != i0 && p[k] > p1) { p1 = p[k]; i1 = k; }
            const float sm = p0 + p1;
            e0 = gs * 8 + i0; e1 = gs * 8 + i1; ga0 = pg * p0 / sm; ga1 = pg * p1 / sm;
            if (hh == 0) { rk0 = __hip_atomic_fetch_add(lcnt + e0, 1, __ATOMIC_RELAXED, __HIP_MEMORY_SCOPE_WORKGROUP); rk1 = __hip_atomic_fetch_add(lcnt + e1, 1, __ATOMIC_RELAXED, __HIP_MEMORY_SCOPE_WORKGROUP); }
        }
        __syncthreads();
        if (F.tid < 32) { const int c = lcnt[F.tid]; lbase[F.tid] = c ? (int)__hip_atomic_fetch_add(gcnt + F.tid, (unsigned)c, RLX_AGENT) : 0; }
        __syncthreads();
        if (w < 4 && hh == 0) { const int s0 = lbase[e0] + rk0, s1 = lbase[e1] + rk1;
            P.TE()[2 * tok] = e0; P.TE()[2 * tok + 1] = e1; P.TS()[2 * tok] = s0; P.TS()[2 * tok + 1] = s1; P.TG()[2 * tok] = ga0; P.TG()[2 * tok + 1] = ga1;
            P.RT()[(size_t)e0 * ECAP + s0] = tok; P.RT()[(size_t)e1 * ECAP + s1] = tok; }
        __syncthreads();
    }
}

__device__ __forceinline__ void moe_setup(Frame& F, int cslot) {
    volatile LAS int* lc = (volatile LAS int*)(F.lds + LDSCTL_OFF);
    if (F.tid == 0) { int run = 0;
        for (int e = 0; e < NE; ++e) { const int c = (int)__hip_atomic_load(F.ctl + CW_CNT + 64 * cslot + e, RLX_AGENT); lc[LC_CNT + e] = c; lc[LC_PSTART + e] = run; run += (c + 255) >> 8; }
        lc[LC_PSTART + NE] = run; }
    __syncthreads();
}
constexpr bool MOE_HYBRID = false;
struct MoeSched {
    volatile LAS int* lc; int G, c, mode; const char* A; const char* Wt; const int* RT; unsigned* gate;
    static constexpr bool HOOKS = true;
    __device__ bool next(int i, pg8::Unit& u) const {
        const int npb = lc[LC_PSTART + NE], nu = 2 * npb, nlu = MOE_HYBRID ? nu % G : 0, nua = nu - nlu;
        int pblk, pn; u.dep = 0; u.sig = 0;
        if (mode == 0) { const int L = i * G + c; if (L >= nua) return false; pblk = L >> 1; pn = L & 1; }
        else if (mode == 1) { if (i > 0 || c >= nlu) return false; const int L = nua + c; pblk = L >> 1; pn = L & 1; u.sig = 1; }
        else { const int gh = G - nlu; const int q = (c >= nlu) ? (i < 3 ? i * gh + (c - nlu) : 3 * gh + (i - 3) * G + c) : (3 * gh + i * G + c);
            if (q >= 4 * npb) return false; pblk = q >> 2; pn = q & 3; u.dep = (2 * pblk >= nua) ? 1 : 0; }
        int e = 0; while (lc[LC_PSTART + e + 1] <= pblk) ++e;
        const int blk = pblk - lc[LC_PSTART + e];
        u.pm = pblk; u.pn = pn;
        if (mode < 2) { u.a = A; u.rows = RT + (size_t)e * ECAP + blk * 256; const int n = lc[LC_CNT + e] - blk * 256; u.nrows = n < 256 ? n : 256; u.b = Wt + ((size_t)e * 512 + pn * 256) * D * 2; }
        else { u.a = A + (size_t)pblk * 256 * DE * 2; u.rows = nullptr; u.nrows = 256; u.b = Wt + ((size_t)e * D + pn * 256) * DE * 2; }
        return true;
    }
    __device__ __forceinline__ void done(const pg8::Unit& u) const {
        if (u.sig) { asm volatile("s_waitcnt vmcnt(0)" ::: "memory");
            if ((threadIdx.x & 63) == 0) { __builtin_amdgcn_fence(__ATOMIC_RELEASE, "agent"); asm volatile("s_waitcnt vmcnt(0)" ::: "memory"); __hip_atomic_fetch_add(gate, 1u, RLX_AGENT); } }
    }
    __device__ __forceinline__ void a_ready(const pg8::Unit& u) const {
        if (u.dep) { const int npb = lc[LC_PSTART + NE], nlu = MOE_HYBRID ? (2 * npb) % G : 0; const unsigned want = 8u * (unsigned)nlu;
            unsigned spins = 0u;
            while (__hip_atomic_load(gate, RLX_AGENT) < want && ++spins < (1u << 22)) __builtin_amdgcn_s_sleep(4);
            __builtin_amdgcn_fence(__ATOMIC_ACQUIRE, "agent"); asm volatile("s_waitcnt vmcnt(0)" ::: "memory"); }
    }
};

template <bool LFL>
__device__ __forceinline__ void combine_phase(Frame& F, const Ptrs& P, int layer, float* Xo) {
    volatile LAS int* lc = (volatile LAS int*)(F.lds + LDSCTL_OFF);
    WfRegs R; if (LFL) load_wf(R, P.w_in() + (size_t)(layer + 1) * D * PWIN, F.lane);
    f32x4 g2[4], b2[4]; load_gb(g2, b2, P.ln2_g() + (size_t)layer * D, P.ln2_b() + (size_t)layer * D, F.lane); const f32x4 bf = LFL ? *(const f32x4*)(P.b_f() + (layer + 1) * 4) : (f32x4){0.f, 0.f, 0.f, 0.f};
    const int gw = F.vcu * 8 + F.wave, NGW = F.G * 8, lane = F.lane;
    const int* TE = P.TE(); const int* TS = P.TS(); const float* TG = P.TG(); const bf16* O = P.O(); bf16* XN = P.XN(); float* LF = P.LF();
    struct Meta { v2u e, s; f32x2 g; }; struct Data { v2u x[4], a[4], b[4]; };
#define LD_META(M, m) do { (M).e = *(const v2u*)(TE + 2 * (size_t)(m)); (M).s = *(const v2u*)(TS + 2 * (size_t)(m)); (M).g = *(const f32x2*)(TG + 2 * (size_t)(m)); } while (0)
#define LD_DATA(Dd, M, m) do { const size_t r0_ = (size_t)lc[LC_PSTART + (int)(M).e.x] * 256 + (M).s.x, r1_ = (size_t)lc[LC_PSTART + (int)(M).e.y] * 256 + (M).s.y; \
        _Pragma("unroll") for (int j = 0; j < 4; ++j) { (Dd).x[j] = *(const v2u*)(XN + (size_t)(m) * D + 4 * lane + 256 * j); (Dd).a[j] = *(const v2u*)(O + r0_ * D + 4 * lane + 256 * j); (Dd).b[j] = *(const v2u*)(O + r1_ * D + 4 * lane + 256 * j); } } while (0)
    Meta M0, M1, M2; Data D0, D1;
    if (gw < T) { LD_META(M0, gw); LD_DATA(D0, M0, gw); }
    if (gw + NGW < T) LD_META(M1, gw + NGW);
    for (int m = gw; m < T; m += NGW) {
        if (m + 2 * NGW < T) LD_META(M2, m + 2 * NGW);
        if (m + NGW < T) LD_DATA(D1, M1, m + NGW);
        f32x4 v[4]; const float ga0 = M0.g.x, ga1 = M0.g.y;
#pragma unroll
        for (int j = 0; j < 4; ++j) { const v2u xq = D0.x[j]; const f32x4 x = {bflo(xq.x), bfhi(xq.x), bflo(xq.y), bfhi(xq.y)}; const v2u a = D0.a[j], b = D0.b[j];
            v[j].x = ALPHA * x.x + ga0 * bflo(a.x) + ga1 * bflo(b.x); v[j].y = ALPHA * x.y + ga0 * bfhi(a.x) + ga1 * bfhi(b.x);
            v[j].z = ALPHA * x.z + ga0 * bflo(a.y) + ga1 * bflo(b.y); v[j].w = ALPHA * x.w + ga0 * bfhi(a.y) + ga1 * bfhi(b.y); }
        finish_row<LFL ? 1 : 0, !LFL, LFL>(v, g2, b2, Xo + (size_t)m * D, XN + (size_t)m * D, R, bf, LF + (size_t)m * 4, lane);
        M0 = M1; M1 = M2; D0 = D1;
    }
#undef LD_META
#undef LD_DATA
}

__global__ void __launch_bounds__(512, 2) mk_fwd(Args args) {
    extern __shared__ __attribute__((aligned(16))) unsigned char lds[];
    Frame F;
    F.lds = (LAS unsigned char*)lds; F.lds_gen = lds;
    F.MISC = (volatile LAS unsigned*)(F.lds + MISC_OFF);
    F.tid = threadIdx.x; F.lane = F.tid & 63; F.wave = __builtin_amdgcn_readfirstlane(F.tid >> 6);
    F.G = gridDim.x; { const int bx = blockIdx.x; F.vcu = (F.G % 8 == 0) ? (bx % 8) * (F.G / 8) + bx / 8 : bx; }
    F.ws = args.ws; F.X = args.out; F.ctl = (unsigned*)(args.ws + WS_CTL);
    for (int u = F.tid; u < (LDS_BYTES - LDSCTL_OFF) / 4; u += 512) ((LAS unsigned*)(F.lds + LDSCTL_OFF))[u] = 0u;
    __syncthreads();
    if (F.tid < 24) { const unsigned long long pv = (unsigned long long)args.in[F.tid]; ((LAS unsigned*)(F.lds + PTAB_OFF))[2 * F.tid] = (unsigned)pv; ((LAS unsigned*)(F.lds + PTAB_OFF))[2 * F.tid + 1] = (unsigned)(pv >> 32); }
    __syncthreads();
    Ptrs P; P.tab = (volatile LAS unsigned*)(F.lds + PTAB_OFF); P.ws = args.ws;
    XcdBarrier bar = xcd_barrier_post(F.ctl + CW_BAR, F.MISC + 8);
    const int hi = args.ph_hi; int ph = 0;
#define PHASE_END() do { ++ph; if (ph >= hi) return; xcd_barrier(bar); asm volatile("" : "+v"(F.tid)); F.lane = F.tid & 63; F.wave = __builtin_amdgcn_readfirstlane(F.tid >> 6); } while (0)

#define RUN_P0() do { p0_weights(F, P); p0_rows(F, P); } while (0)
#define RUN_G1(layer) do { for (int bh = F.G - 1 - (int)blockIdx.x; bh < NB * NH; bh += F.G) c2_scan(F, P, bh); pg8::StaticOrder So; So.init(P.XN(), P.WIN() + (size_t)(layer) * NPROJ * D, T, NPROJ, D, F.G, (int)blockIdx.x); EpiProj E{P.PROJ(), F.ctl + CW_KINF + 128 * (layer)}; \
        pg8::gemm_phase<EpiProj, pg8::StaticOrder, false>(F.lds, D, So, E, F.tid); moe_cvt_tail(F, P, layer, 0); moe_cvt_tail(F, P, layer, 1); } while (0)
#define RUN_G2(layer) do { pg8::StaticOrder So; So.init(P.MIX(), P.WOUT() + (size_t)(layer) * D * D, T, D, D, F.G, (int)blockIdx.x); EpiRes E{P.MOUT(), P.SS(), (LAS float*)(F.lds + LDSCTL_OFF + 2048)}; \
        pg8::gemm_phase<EpiRes, pg8::StaticOrder, false>(F.lds, D, So, E, F.tid); } while (0)
#define RUN_U(layer, cslot, gslot) do { moe_setup(F, cslot); MoeSched Ms{(volatile LAS int*)(F.lds + LDSCTL_OFF), F.G, F.vcu, 0, (const char*)P.XN(), (const char*)(P.W13() + (size_t)(layer) * NE * 512 * D), P.RT(), F.ctl + CW_GATE + 64 * (gslot)}; EpiSwiglu E{P.H()}; \
        pg8::gemm_phase<EpiSwiglu, MoeSched, true>(F.lds, D, Ms, E, F.tid); } while (0)
#define RUN_DN(layer, gslot) do { { MoeSched Ml{(volatile LAS int*)(F.lds + LDSCTL_OFF), F.G, F.vcu, 1, (const char*)P.XN(), (const char*)(P.W13() + (size_t)(layer) * NE * 512 * D), P.RT(), F.ctl + CW_GATE + 64 * (gslot)}; EpiSwiglu El{P.H()}; \
        pg8::gemm_phase<EpiSwiglu, MoeSched, true>(F.lds, D, Ml, El, F.tid); } \
        MoeSched Ms{(volatile LAS int*)(F.lds + LDSCTL_OFF), F.G, F.vcu, 2, (const char*)P.H(), (const char*)(P.W2() + (size_t)(layer) * NE * D * DE), nullptr, F.ctl + CW_GATE + 64 * (gslot)}; EpiBf E{P.O()}; \
        pg8::gemm_phase<EpiBf, MoeSched, false>(F.lds, DE, Ms, E, F.tid); } while (0)
    RUN_P0();
    PHASE_END();
#define LAYER_BODY(layer, LAST) do { \
        RUN_G1(layer); PHASE_END(); \
        mixer_phase(F, P, layer, layer); PHASE_END(); \
        RUN_G2(layer); PHASE_END(); \
        router_phase(F, P, layer, layer); PHASE_END(); \
        RUN_U(layer, layer, layer); PHASE_END(); \
        RUN_DN(layer, layer); PHASE_END(); \
        if (!(LAST)) { combine_phase<true>(F, P, layer, nullptr); PHASE_END(); } else combine_phase<false>(F, P, layer, F.X); } while (0)
    LAYER_BODY(0, false);
    LAYER_BODY(1, true);
#if MK_XP
    {
        float* Xd = (float*)(F.ws + WS_PROJ);
        for (int rep = 0; rep < MK_XR; ++rep) {
            const int sl = 2 + rep; PHASE_END();
            if (MK_XP & 2048) { for (int q = 0; q < 10; ++q) PHASE_END(); }
            if (MK_XP & 1) { RUN_P0(); PHASE_END(); }
            if (MK_XP & 2) { RUN_G1(1); PHASE_END(); }
            if (MK_XP & 4) { mixer_phase<MK_AMODE>(F, P, 1, sl, MK_ULO, MK_UHI); PHASE_END(); }
            if (MK_XP & 8) { norm_phase(F, P); PHASE_END(); }
            if (MK_XP & 16) { RUN_G2(1); PHASE_END(); }
            if (MK_XP & 32) { router_phase<MK_RMODE>(F, P, 1, sl); PHASE_END(); }
            if (MK_XP & 64) { RUN_U(1, 1, sl); PHASE_END(); }
            if (MK_XP & 512) { moe_setup(F, 1); MoeSched Ms{(volatile LAS int*)(F.lds + LDSCTL_OFF), F.G, F.vcu, 0, (const char*)P.XN(), (const char*)(P.W13() + (size_t)(1) * NE * 512 * D), P.RT(), F.ctl + CW_GATE + 64 * sl}; EpiNone E{(float*)P.H()};
                pg8::gemm_phase<EpiNone, MoeSched, true>(F.lds, D, Ms, E, F.tid); PHASE_END(); }
            if (MK_XP & 1024) { pg8::StaticOrder So; So.init(P.XN(), P.WIN() + (size_t)(1) * NPROJ * D, T, NPROJ, D, F.G, (int)blockIdx.x); EpiNone E{(float*)P.H()};
                pg8::gemm_phase<EpiNone, pg8::StaticOrder, false>(F.lds, D, So, E, F.tid); PHASE_END(); }
            if (MK_XP & 128) { RUN_DN(1, sl); PHASE_END(); }
            if (MK_XP & 256) { moe_setup(F, 1); combine_phase<false>(F, P, 1, Xd); }
        }
    }
#endif
#undef PHASE_END
}

extern "C" void kernel_launch(void* const* d_in, const int* in_sizes, int n_in, void* d_out, int out_size, void* d_ws, size_t ws_size, hipStream_t stream) {
    static int grid = 0;
    if (grid == 0) {
        if (n_in != 24 || out_size != T * D || ws_size < WS_END) { fprintf(stderr, "kernel_launch: unexpected problem (n_in %d out %d ws %zu)\n", n_in, out_size, ws_size); grid = -1; return; }
        int dev = 0, cus = 0;
        if (hipGetDevice(&dev) != hipSuccess || hipDeviceGetAttribute(&cus, hipDeviceAttributeMultiprocessorCount, dev) != hipSuccess) { grid = -1; return; }
        if (hipFuncSetAttribute((const void*)mk_fwd, hipFuncAttributeMaxDynamicSharedMemorySize, LDS_BYTES) != hipSuccess) { fprintf(stderr, "kernel_launch: hipFuncSetAttribute failed\n"); grid = -1; return; }
        int per_cu = 0; (void)hipOccupancyMaxActiveBlocksPerMultiprocessor(&per_cu, (const void*)mk_fwd, 512, LDS_BYTES); (void)hipGetLastError();
        if (per_cu < 1) fprintf(stderr, "kernel_launch: occupancy query says %d blocks/CU\n", per_cu);
        grid = cus;
    }
    if (grid < 0) return;
    (void)hipMemsetAsync((char*)d_ws + WS_CTL, 0, CTL_ZERO_BYTES, stream);
    Args a{};
    for (int i = 0; i < 24; ++i) a.in[i] = (const float*)d_in[i];
    a.out = (float*)d_out; a.ws = (unsigned char*)d_ws; a.ph_lo = 0; a.ph_hi = MK_PH_HI;
    hipLaunchKernelGGL(mk_fwd, dim3(grid), dim3(512), LDS_BYTES, stream, a);
#ifdef MK_DEBUG_TAIL
    MK_DEBUG_TAIL
#endif
}
```

```cpp
#ifndef MK_PH_HI
#define MK_PH_HI 1000
#endif
#ifndef MK_XP
#define MK_XP 0
#endif
#ifndef MK_XR
#define MK_XR 1
#endif
#ifndef MK_STAGGER_TICKS
#define MK_STAGGER_TICKS 1200
#endif
#ifndef MK_NT_STORE
#define MK_NT_STORE 0
#endif
#ifndef MK_AMODE
#define MK_AMODE 0
#endif
#ifndef MK_ROUTER_LO
#define MK_ROUTER_LO 0
#endif
#ifndef MK_RMODE
#define MK_RMODE 0
#endif
#ifndef MK_ULO
#define MK_ULO 0
#define MK_UHI 1000000
#endif
#include <hip/hip_runtime.h>
#include <cstdio>
#include <cstdint>
#include <cmath>

constexpr int D = 1024, NB = 16, S = 2048, T = NB * S, NL = 2;
constexpr int GW = 256, NH = 4, HD = 64, PWIN = 2820, NPROJ = 2816;
constexpr int NE = 32, DE = 256, ECAP = 65536, PMAX = 73728;
constexpr float LN_EPS = 1e-5f, RMS_EPS = 1e-6f;
constexpr float ALPHA = 1.4142135623730951f;
constexpr float LOG2E = 1.4426950408889634f;
constexpr float C2 = 0.125f * LOG2E;

namespace pg8 {
#define PG8_LAS __attribute__((address_space(3)))
typedef unsigned short bf16_t;
typedef short bf16x8 __attribute__((ext_vector_type(8)));
typedef float f32x4 __attribute__((ext_vector_type(4)));
typedef float f32x2 __attribute__((ext_vector_type(2)));
typedef unsigned u32x4 __attribute__((ext_vector_type(4)));
constexpr int BM = 256, BK = 64, HALF = 128, HTB = HALF * BK * 2, STAGE_BYTES = 8 * HTB, NXCD = 8, WGM = 8;

__host__ __device__ __forceinline__ int lds_byte(int r, int c) { const int st = (r >> 4) * 2 + (c >> 5), rr = r & 15, cc = c & 31, ob = rr * 64 + cc * 2; return st * 1024 + (ob ^ (((ob >> 9) & 1) << 5)); }
__host__ __device__ __forceinline__ void stage_rc(int b, int& R, int& C) { const int st = b / 1024, sb = b % 1024, swz = sb ^ (((sb >> 9) & 1) << 5); R = (st >> 1) * 16 + swz / 64; C = (st & 1) * 32 + (swz % 64) / 2; }
__host__ __device__ __forceinline__ int perm32(int rho) { const int n = rho >> 4, i = rho & 15; return 8 * (i >> 2) + 4 * n + (i & 3); }

struct Unit { int pm, pn; const char* a; const char* b; const int* rows; int nrows; int dep, sig; };

__device__ __forceinline__ unsigned cvt_pk_bf16(float lo, float hi) { unsigned r; asm volatile("v_cvt_pk_bf16_f32 %0, %1, %2" : "=v"(r) : "v"(lo), "v"(hi)); return r; }

struct StaticOrder {
    int nM, nN, nwg, G, c; const char* A; const char* Bt; size_t tstep;
    __device__ void init(const void* A_, const void* Bt_, int M, int N, int K, int G_, int c_) { nM = M / BM; nN = N / BM; nwg = nM * nN; G = G_; c = c_; A = (const char*)A_; Bt = (const char*)Bt_; tstep = (size_t)BM * K * 2; }
    __device__ bool next(int i, Unit& u) const {
        const long L = (long)i * G + c; if (L >= nwg) return false;
        int wgid = (int)L; { const int q = nwg / NXCD, r = nwg % NXCD, xcd = wgid % NXCD, off = wgid / NXCD; wgid = (xcd < r ? xcd * (q + 1) : r * (q + 1) + (xcd - r) * q) + off; }
        const int nig = WGM * nN, gid = wgid / nig, fm = gid * WGM, gsz = (nM - fm) < WGM ? (nM - fm) : WGM;
        u.pm = fm + ((wgid % nig) % gsz); u.pn = (wgid % nig) / gsz; u.a = A + (size_t)u.pm * tstep; u.b = Bt + (size_t)u.pn * tstep; u.rows = nullptr; u.nrows = BM; u.dep = 0; u.sig = 0; return true;
    }
    static constexpr bool HOOKS = false;
    __device__ __forceinline__ void a_ready(const Unit&) const {}
    __device__ __forceinline__ void done(const Unit&) const {}
};

template <class Epi, class Sched, bool GATHER, bool ALIGN_EPI = true>
__device__ __forceinline__ void gemm_phase(PG8_LAS unsigned char* lds, const int K, const Sched& S, const Epi& E, const int tid) {
    const int wid = __builtin_amdgcn_readfirstlane(tid >> 6), lane = tid & 63, wr = wid >> 2, wc = wid & 3, fr = lane & 15, fq = lane >> 4;
    const int nt = K / BK;
    unsigned voffA[2][2], voffB[2];
#pragma unroll
    for (int i = 0; i < 2; ++i) { int R, C; stage_rc(tid * 16 + i * 8192, R, C); const int Rb = Epi::PERM ? ((R & ~31) + perm32(R & 31)) : R;
        voffA[0][i] = (unsigned)(R * K + C) * 2u; voffA[1][i] = (unsigned)((R + HALF) * K + C) * 2u; voffB[i] = (unsigned)(Rb * K + C) * 2u; }
    const size_t kstep = (size_t)(BK * 2);
    const size_t hstep = (size_t)HALF * K * 2;
    const unsigned ldsw = (unsigned)wid * 1024u;
    const int aoff = lds_byte(wr * 64 + fr, fq * 8), boff = lds_byte(wc * 32 + fr, fq * 8);
#define PG8_SA(b, h) (((b) * 2 + (h)) * HTB)
#define PG8_SB(b, h) ((4 + (b) * 2 + (h)) * HTB)
#define PG8_STAGE(bufoff, gbase, voff) do { _Pragma("unroll") for (int _i = 0; _i < 2; ++_i) \
        __builtin_amdgcn_global_load_lds((const unsigned*)((const char*)(gbase) + (voff)[_i]), (PG8_LAS unsigned*)(lds + (bufoff) + ldsw + _i * 8192), 16, 0, 0); } while (0)
#define PG8_LDA(dst, b, h) do { _Pragma("unroll") for (int m = 0; m < 4; ++m) _Pragma("unroll") for (int k = 0; k < 2; ++k) dst[m][k] = *(const PG8_LAS bf16x8*)(lds + PG8_SA(b, h) + aoff + m * 2048 + k * 1024); } while (0)
#define PG8_LDB(dst, b, h) do { _Pragma("unroll") for (int n = 0; n < 2; ++n) _Pragma("unroll") for (int k = 0; k < 2; ++k) dst[n][k] = *(const PG8_LAS bf16x8*)(lds + PG8_SB(b, h) + boff + n * 2048 + k * 1024); } while (0)
#define PG8_MMA(ai, bj, At, Bt) do { __builtin_amdgcn_s_setprio(1); _Pragma("unroll") for (int m = 0; m < 4; ++m) _Pragma("unroll") for (int n = 0; n < 2; ++n) _Pragma("unroll") for (int k = 0; k < 2; ++k) \
        acc[ai][bj][m][n] = __builtin_amdgcn_mfma_f32_16x16x32_bf16(Bt[n][k], At[m][k], acc[ai][bj][m][n], 0, 0, 0); __builtin_amdgcn_s_setprio(0); } while (0)
#define PG8_WAIT_V(n) asm volatile("s_waitcnt vmcnt(" #n ")" ::: "memory")
#define PG8_WAIT_L(n) asm volatile("s_waitcnt lgkmcnt(" #n ")" ::: "memory")
#define PG8_BAR __builtin_amdgcn_s_barrier()
#define PG8_SCHED __builtin_amdgcn_sched_barrier(0)
#define PG8_GLOAD(ids, u) do { int _t2 = tid; asm volatile("" : "+v"(_t2)); _Pragma("unroll") for (int _i = 0; _i < 2; ++_i) { int _R, _C; stage_rc(_t2 * 16 + _i * 8192, _R, _C); \
        _Pragma("unroll") for (int _h = 0; _h < 2; ++_h) { const int _r = _R + _h * HALF; ids[_h][_i] = (_r < (u).nrows) ? (u).rows[_r] : 0; } } } while (0)
#define PG8_GSET(dst, ids) do { int _t2 = tid; asm volatile("" : "+v"(_t2)); _Pragma("unroll") for (int _i = 0; _i < 2; ++_i) { int _R, _C; stage_rc(_t2 * 16 + _i * 8192, _R, _C); \
        _Pragma("unroll") for (int _h = 0; _h < 2; ++_h) dst[_h][_i] = (unsigned)(ids[_h][_i] * K + _C) * 2u; } } while (0)
    Unit cur, nxt; int ui = 0;
    if (!S.next(0, cur)) return;
    f32x4 acc[2][2][4][2];
#pragma unroll
    for (int a = 0; a < 2; ++a)
#pragma unroll
        for (int b = 0; b < 2; ++b)
#pragma unroll
            for (int m = 0; m < 4; ++m)
#pragma unroll
                for (int n = 0; n < 2; ++n) acc[a][b][m][n] = (f32x4){0.f, 0.f, 0.f, 0.f};
    bf16x8 At[4][2], B0[2][2], B1[2][2];
    const char* cA = cur.a; const char* cB = cur.b;
    if constexpr (Sched::HOOKS) S.a_ready(cur);
    int gids[2][2];
    if constexpr (GATHER) { PG8_GLOAD(gids, cur); PG8_GSET(voffA, gids); }
    PG8_STAGE(PG8_SB(0, 0), cB, voffB); PG8_STAGE(PG8_SB(0, 1), cB + hstep, voffB); PG8_STAGE(PG8_SA(0, 0), cA, voffA[0]); PG8_STAGE(PG8_SA(0, 1), cA, voffA[1]);
    if (wr == 1) PG8_BAR;
    PG8_WAIT_V(2); PG8_BAR;
    PG8_STAGE(PG8_SB(1, 0), cB + kstep, voffB); PG8_STAGE(PG8_SA(1, 0), cA + kstep, voffA[0]); PG8_STAGE(PG8_SB(1, 1), cB + hstep + kstep, voffB);
    PG8_WAIT_V(6); PG8_BAR;
    for (;;) {
        const bool has_next = S.next(ui + 1, nxt);
        if constexpr (Epi::KSCALE) E.kscale_begin(cur, tid);
        if constexpr (GATHER) { if (has_next) { PG8_GLOAD(gids, nxt); } }
        const char* nA = has_next ? nxt.a : cA; const char* nB = has_next ? nxt.b : cB;
#pragma nounroll
        for (int t = 0; t < nt; t += 2) {
            const bool last = (t == nt - 2);
            const char* a1 = cA + (size_t)(t + 1) * kstep;
            const char* a2 = last ? nA : cA + (size_t)(t + 2) * kstep; const char* b2 = last ? nB : cB + (size_t)(t + 2) * kstep;
            const char* a3 = a2 + kstep; const char* b3 = b2 + kstep;
            if constexpr (Sched::HOOKS) { if (last && has_next) S.a_ready(nxt); }
            PG8_LDB(B0, 0, 0); PG8_LDB(B1, 0, 1); PG8_SCHED; PG8_LDA(At, 0, 0); PG8_STAGE(PG8_SA(1, 1), a1, voffA[1]);
            if constexpr (GATHER) { if (last && has_next) { PG8_GSET(voffA, gids); } }
            PG8_WAIT_V(8); PG8_WAIT_L(0); PG8_BAR; PG8_MMA(0, 0, At, B0); PG8_MMA(0, 1, At, B1); PG8_BAR; PG8_SCHED;
            PG8_LDA(At, 0, 1); PG8_STAGE(PG8_SB(0, 0), b2, voffB); PG8_STAGE(PG8_SB(0, 1), b2 + hstep, voffB); PG8_STAGE(PG8_SA(0, 0), a2, voffA[0]);
            PG8_WAIT_V(8); PG8_WAIT_L(0); PG8_BAR; PG8_MMA(1, 0, At, B0); PG8_MMA(1, 1, At, B1); PG8_BAR; PG8_SCHED;
            PG8_LDB(B0, 1, 0); PG8_LDB(B1, 1, 1); PG8_SCHED; PG8_LDA(At, 1, 0); PG8_STAGE(PG8_SA(0, 1), a2, voffA[1]);
            PG8_WAIT_V(8); PG8_WAIT_L(0); PG8_BAR; PG8_MMA(0, 0, At, B0); PG8_MMA(0, 1, At, B1); PG8_BAR; PG8_SCHED;
            PG8_LDA(At, 1, 1); PG8_STAGE(PG8_SB(1, 0), b3, voffB); PG8_STAGE(PG8_SB(1, 1), b3 + hstep, voffB); PG8_STAGE(PG8_SA(1, 0), a3, voffA[0]);
            PG8_WAIT_V(8); PG8_WAIT_L(0); PG8_BAR; PG8_MMA(1, 0, At, B0); PG8_MMA(1, 1, At, B1); PG8_BAR; PG8_SCHED;
            if constexpr (Epi::KSCALE) { if (t == 2 || t == 6) { PG8_SCHED; E.kscale(acc, t == 6 ? 1 : 0, wr, fr); PG8_SCHED; } }
        }
        if constexpr (ALIGN_EPI) { if (wr == 0) PG8_BAR; }
        E(acc, cur, wr, wc, fr, fq);
        if constexpr (Sched::HOOKS) S.done(cur);
        if (!has_next) break;
#pragma unroll
        for (int a = 0; a < 2; ++a)
#pragma unroll
            for (int b = 0; b < 2; ++b)
#pragma unroll
                for (int m = 0; m < 4; ++m)
#pragma unroll
                    for (int n = 0; n < 2; ++n) acc[a][b][m][n] = (f32x4){0.f, 0.f, 0.f, 0.f};
        cur = nxt; cA = nA; cB = nB; ++ui;
        if constexpr (ALIGN_EPI) { if (wr == 1) PG8_BAR; }
    }
    PG8_WAIT_V(0);
    if constexpr (!ALIGN_EPI) { if (wr == 0) PG8_BAR; }
    PG8_BAR;
#undef PG8_SA
#undef PG8_SB
#undef PG8_STAGE
#undef PG8_LDA
#undef PG8_LDB
#undef PG8_MMA
#undef PG8_WAIT_V
#undef PG8_WAIT_L
#undef PG8_BAR
#undef PG8_SCHED
#undef PG8_GLOAD
#undef PG8_GSET
}
}
#define GAS __attribute__((address_space(1)))
#define LAS __attribute__((address_space(3)))
typedef unsigned short bf16;
typedef unsigned v4u __attribute__((ext_vector_type(4)));
typedef unsigned v2u __attribute__((ext_vector_type(2)));
typedef float f32x4 __attribute__((ext_vector_type(4)));
typedef float f32x2 __attribute__((ext_vector_type(2)));
typedef float f32x16 __attribute__((ext_vector_type(16)));
typedef short bf16x8 __attribute__((ext_vector_type(8)));
typedef short s16x4 __attribute__((ext_vector_type(4)));
typedef GAS unsigned gu32;
#define RLX_AGENT __ATOMIC_RELAXED, __HIP_MEMORY_SCOPE_AGENT
#define LDS_WAIT() asm volatile("s_waitcnt lgkmcnt(0)" ::: "memory")
#define VM_WAIT() asm volatile("s_waitcnt vmcnt(0)" ::: "memory")
__device__ __forceinline__ unsigned f2bf(float f) { unsigned u = __builtin_bit_cast(unsigned, f); return (u + 0x7fffu + ((u >> 16) & 1u)) >> 16; }
typedef __bf16 bf16x2_t __attribute__((ext_vector_type(2)));
__device__ __forceinline__ unsigned pk2(float lo, float hi) { f32x2 v = {lo, hi}; bf16x2_t b = __builtin_convertvector(v, bf16x2_t); return __builtin_bit_cast(unsigned, b); }
__device__ __forceinline__ float bf2f(unsigned h) { return __builtin_bit_cast(float, h << 16); }
__device__ __forceinline__ float bflo(unsigned w) { return __builtin_bit_cast(float, w << 16); }
__device__ __forceinline__ float bfhi(unsigned w) { return __builtin_bit_cast(float, w & 0xffff0000u); }
template <int CTRL> __device__ __forceinline__ float dpp_mov(float v) { return __int_as_float(__builtin_amdgcn_update_dpp(0, __float_as_int(v), CTRL, 0xF, 0xF, true)); }
__device__ __forceinline__ float wave_sum(float v) {
    v += dpp_mov<0xB1>(v); v += dpp_mov<0x4E>(v); v += dpp_mov<0x141>(v); v += dpp_mov<0x140>(v);
    { auto s = __builtin_amdgcn_permlane16_swap(__float_as_uint(v), __float_as_uint(v), false, false); v = __uint_as_float(s[0]) + __uint_as_float(s[1]); }
    { auto s = __builtin_amdgcn_permlane32_swap(__float_as_uint(v), __float_as_uint(v), false, false); v = __uint_as_float(s[0]) + __uint_as_float(s[1]); }
    return v;
}
__device__ __forceinline__ float wave_max(float v) {
    v = fmaxf(v, dpp_mov<0xB1>(v)); v = fmaxf(v, dpp_mov<0x4E>(v)); v = fmaxf(v, dpp_mov<0x141>(v)); v = fmaxf(v, dpp_mov<0x140>(v));
    { auto s = __builtin_amdgcn_permlane16_swap(__float_as_uint(v), __float_as_uint(v), false, false); v = fmaxf(__uint_as_float(s[0]), __uint_as_float(s[1])); }
    { auto s = __builtin_amdgcn_permlane32_swap(__float_as_uint(v), __float_as_uint(v), false, false); v = fmaxf(__uint_as_float(s[0]), __uint_as_float(s[1])); }
    return v;
}
__device__ __forceinline__ float other_half(float x) {
    auto rr = __builtin_amdgcn_permlane32_swap(__float_as_uint(x), __float_as_uint(x), false, false);
    return __uint_as_float((threadIdx.x & 32) ? rr[0] : rr[1]);
}
__device__ __forceinline__ float log_sigmoid_f(float x) { return fminf(x, 0.f) - log1pf(__expf(-fabsf(x))); }
__device__ __forceinline__ float gelu_tanh_f(float x) {
    const float u = x * (1.0f + 0.044715f * x * x);
    const float e = __builtin_amdgcn_exp2f(u * (-2.0f * 0.7978845608028654f * LOG2E));
    return x * __builtin_amdgcn_rcpf(1.0f + e);
}

#if MK_NT_STORE
#define MK_STORE16(p, v) __builtin_nontemporal_store((v), (p))
#else
#define MK_STORE16(p, v) (*(p) = (v))
#endif
struct EpiProj {
    static constexpr bool PERM = true, KSCALE = false; static constexpr int NSTORE = 16;
    bf16* O; unsigned* kinf;
    __device__ __forceinline__ void operator()(const pg8::f32x4 (&acc)[2][2][4][2], const pg8::Unit& u, int wr, int wc, int fr, int fq) const {
        const int row0 = u.pm * 256 + wr * 64 + fr, col0 = u.pn * 256 + wc * 32 + 8 * fq;
        const float sc = (u.pn == 0 || u.pn == 3) ? C2 : 1.f; const bool g = u.pn >= 9;
        if (u.pn == 4) {
#pragma unroll
            for (int bj = 0; bj < 2; ++bj) { float mx = 0.f;
#pragma unroll
                for (int ai = 0; ai < 2; ++ai)
#pragma unroll
                    for (int m = 0; m < 4; ++m) { float s = 0.f;
#pragma unroll
                        for (int n = 0; n < 2; ++n)
#pragma unroll
                            for (int e = 0; e < 4; ++e) s += acc[ai][bj][m][n][e] * acc[ai][bj][m][n][e];
                        { auto t = __builtin_amdgcn_permlane16_swap(__float_as_uint(s), __float_as_uint(s), false, false); s = __uint_as_float(t[0]) + __uint_as_float(t[1]); }
                        { auto t = __builtin_amdgcn_permlane32_swap(__float_as_uint(s), __float_as_uint(s), false, false); s = __uint_as_float(t[0]) + __uint_as_float(t[1]); }
                        mx = fmaxf(mx, s); }
                mx = wave_max(mx);
                if ((threadIdx.x & 63) == 0) atomicMax(kinf + ((u.pm >> 3) * 4 + 2 * bj + (wc >> 1)) * 2 + (wc & 1), __float_as_uint(mx)); } }
        if (u.pn == 6 || u.pn == 7) {
#pragma unroll
            for (int ai = 0; ai < 2; ++ai)
#pragma unroll
                for (int m = 0; m < 4; ++m) { const pg8::f32x4 z0 = acc[ai][0][m][0] * acc[ai][1][m][0], z1 = acc[ai][0][m][1] * acc[ai][1][m][1];
                    v4u w; w.x = pg8::cvt_pk_bf16(z0[0], z0[1]); w.y = pg8::cvt_pk_bf16(z0[2], z0[3]); w.z = pg8::cvt_pk_bf16(z1[0], z1[1]); w.w = pg8::cvt_pk_bf16(z1[2], z1[3]);
                    *(v4u*)(O + (size_t)(row0 + ai * 128 + m * 16) * NPROJ + 1536 + 128 * (u.pn - 6) + wc * 32 + 8 * fq) = w; }
            return; }
#pragma unroll
        for (int ai = 0; ai < 2; ++ai)
#pragma unroll
            for (int m = 0; m < 4; ++m) { bf16* rowp = O + (size_t)(row0 + ai * 128 + m * 16) * NPROJ + col0;
#pragma unroll
                for (int bj = 0; bj < 2; ++bj) { pg8::f32x4 v0 = acc[ai][bj][m][0], v1 = acc[ai][bj][m][1];
                    if (g) {
#pragma unroll
                        for (int e = 0; e < 4; ++e) { v0[e] = gelu_tanh_f(v0[e]); v1[e] = gelu_tanh_f(v1[e]); } }
                    v0 = v0 * sc; v1 = v1 * sc; v4u w; w.x = pg8::cvt_pk_bf16(v0[0], v0[1]); w.y = pg8::cvt_pk_bf16(v0[2], v0[3]); w.z = pg8::cvt_pk_bf16(v1[0], v1[1]); w.w = pg8::cvt_pk_bf16(v1[2], v1[3]);
                    MK_STORE16((v4u*)(rowp + bj * 128), w); } }
    }
};
struct EpiRes {
    static constexpr bool PERM = true, KSCALE = true; static constexpr int NSTORE = 16;
    bf16* X; const float* SS; LAS float* tab;
    __device__ __forceinline__ void kscale_begin(const pg8::Unit& u, int tid) const {
        if (tid < 256) { const f32x4 a = *(const f32x4*)(SS + (size_t)(u.pm * 256 + tid) * 8), b = *(const f32x4*)(SS + (size_t)(u.pm * 256 + tid) * 8 + 4);
            const float rA = rsqrtf(((a.x + a.y) + (a.z + a.w)) * (1.f / GW) + RMS_EPS), rB = rsqrtf(((b.x + b.y) + (b.z + b.w)) * (1.f / GW) + RMS_EPS);
            *(LAS f32x2*)(tab + 2 * tid) = (f32x2){rA / rB, rB}; }
    }
    __device__ __forceinline__ void kscale(pg8::f32x4 (&acc)[2][2][4][2], int which, int wr, int fr) const {
#pragma unroll
        for (int ai = 0; ai < 2; ++ai)
#pragma unroll
            for (int m = 0; m < 4; ++m) { const float s = tab[2 * (ai * 128 + wr * 64 + m * 16 + fr) + which];
#pragma unroll
                for (int bj = 0; bj < 2; ++bj)
#pragma unroll
                    for (int n = 0; n < 2; ++n) acc[ai][bj][m][n] = acc[ai][bj][m][n] * s; }
    }
    __device__ __forceinline__ void operator()(const pg8::f32x4 (&acc)[2][2][4][2], const pg8::Unit& u, int wr, int wc, int fr, int fq) const {
        const int row0 = u.pm * 256 + wr * 64 + fr, col0 = u.pn * 256 + wc * 32 + 8 * fq;
#pragma unroll
        for (int ai = 0; ai < 2; ++ai)
#pragma unroll
            for (int m = 0; m < 4; ++m) { bf16* rowp = X + (size_t)(row0 + ai * 128 + m * 16) * D + col0;
#pragma unroll
                for (int bj = 0; bj < 2; ++bj) { const pg8::f32x4 v0 = acc[ai][bj][m][0], v1 = acc[ai][bj][m][1]; v4u w;
                    w.x = pg8::cvt_pk_bf16(v0[0], v0[1]); w.y = pg8::cvt_pk_bf16(v0[2], v0[3]); w.z = pg8::cvt_pk_bf16(v1[0], v1[1]); w.w = pg8::cvt_pk_bf16(v1[2], v1[3]);
                    *(v4u*)(rowp + bj * 128) = w; } }
    }
};
struct EpiSwiglu {
    static constexpr bool PERM = true, KSCALE = false; static constexpr int NSTORE = 8;
    bf16* Hh;
    __device__ __forceinline__ void operator()(const pg8::f32x4 (&acc)[2][2][4][2], const pg8::Unit& u, int wr, int wc, int fr, int fq) const {
        const int row0 = u.pm * 256 + wr * 64 + fr, col0 = u.pn * 128 + wc * 32 + 8 * fq;
#pragma unroll
        for (int ai = 0; ai < 2; ++ai)
#pragma unroll
            for (int m = 0; m < 4; ++m) { float h[8];
#pragma unroll
                for (int n = 0; n < 2; ++n)
#pragma unroll
                    for (int e = 0; e < 4; ++e) { const float a1 = acc[ai][0][m][n][e], a3 = acc[ai][1][m][n][e];
                        h[n * 4 + e] = a1 * __builtin_amdgcn_rcpf(1.0f + __builtin_amdgcn_exp2f(-LOG2E * a1)) * a3; }
                v4u w; w.x = pg8::cvt_pk_bf16(h[0], h[1]); w.y = pg8::cvt_pk_bf16(h[2], h[3]); w.z = pg8::cvt_pk_bf16(h[4], h[5]); w.w = pg8::cvt_pk_bf16(h[6], h[7]);
                *(v4u*)(Hh + (size_t)(row0 + ai * 128 + m * 16) * DE + col0) = w; }
    }
};
struct EpiBf {
    static constexpr bool PERM = true, KSCALE = false; static constexpr int NSTORE = 16;
    bf16* O;
    __device__ __forceinline__ void operator()(const pg8::f32x4 (&acc)[2][2][4][2], const pg8::Unit& u, int wr, int wc, int fr, int fq) const {
        const int row0 = u.pm * 256 + wr * 64 + fr, col0 = u.pn * 256 + wc * 32 + 8 * fq;
#pragma unroll
        for (int ai = 0; ai < 2; ++ai)
#pragma unroll
            for (int m = 0; m < 4; ++m) { bf16* rowp = O + (size_t)(row0 + ai * 128 + m * 16) * D + col0;
#pragma unroll
                for (int bj = 0; bj < 2; ++bj) { const pg8::f32x4 v0 = acc[ai][bj][m][0], v1 = acc[ai][bj][m][1];
                    v4u w; w.x = pg8::cvt_pk_bf16(v0[0], v0[1]); w.y = pg8::cvt_pk_bf16(v0[2], v0[3]); w.z = pg8::cvt_pk_bf16(v1[0], v1[1]); w.w = pg8::cvt_pk_bf16(v1[2], v1[3]);
                    *(v4u*)(rowp + bj * 128) = w; } }
    }
};

struct EpiNone {
    static constexpr bool PERM = true, KSCALE = false; static constexpr int NSTORE = 8; float* sink;
    __device__ __forceinline__ void operator()(const pg8::f32x4 (&acc)[2][2][4][2], const pg8::Unit& u, int wr, int wc, int fr, int fq) const {
        float s = 0.f;
#pragma unroll
        for (int ai = 0; ai < 2; ++ai)
#pragma unroll
            for (int bj = 0; bj < 2; ++bj)
#pragma unroll
                for (int m = 0; m < 4; ++m)
#pragma unroll
                    for (int n = 0; n < 2; ++n) s += acc[ai][bj][m][n][0] + acc[ai][bj][m][n][3];
        if (s == 12345.678f) sink[0] = s;
    }
};

constexpr size_t MiB = 1u << 20;
constexpr size_t WS_CTL = 0, CTL_ZERO_BYTES = 1 * MiB;
constexpr size_t WS_LF = 1 * MiB;
constexpr size_t WS_SS = 2 * MiB;
constexpr size_t WS_TE = 3 * MiB;
constexpr size_t WS_TS = WS_TE + 256 * 1024, WS_TG = WS_TS + 256 * 1024;
constexpr size_t WS_RT = 4 * MiB;
constexpr size_t WS_RW = 12 * MiB;
constexpr size_t WS_SGW = 13 * MiB;
constexpr size_t WS_GL = 15 * MiB;
constexpr size_t WS_C2 = 14 * MiB;
constexpr size_t WS_WIN = 16 * MiB;
constexpr size_t WS_WOUT = 27 * MiB;
constexpr size_t WS_W13 = 31 * MiB;
constexpr size_t WS_W2 = 95 * MiB;
constexpr size_t WS_XN = 128 * MiB;
constexpr size_t WS_MIX = 192 * MiB;
constexpr size_t WS_PROJ = 256 * MiB;
constexpr size_t WS_H = 432 * MiB;
constexpr size_t WS_END = 468 * MiB;
constexpr int CW_BAR = 4096;
constexpr int CW_QUEUE = 8192;
constexpr int CW_KINF = 9216;
constexpr int CW_GATE = 9472;
constexpr int CW_CNT = 8448;
constexpr int RING_BYTES = 131072, LDSCTL_OFF = RING_BYTES, MISC_OFF = LDSCTL_OFF + 320, LDS_BYTES = 147456;

#define XB_TMO      128
#define XB_XCNT(j)  (256  + 64 * (j))
#define XB_XSUB(j)  (1280 + 64 * (j))
#define XB_XGEN(j)  (2304 + 64 * (j))
#define XB_TOP      3328
#define XB_TOPGEN   3392
#define XCD_BAR_WORDS 3456
#define XB_SPIN_CAP (1u << 18)
__device__ __forceinline__ unsigned xb_ld(unsigned* p)              { return __hip_atomic_load(p, __ATOMIC_RELAXED, __HIP_MEMORY_SCOPE_AGENT); }
__device__ __forceinline__ unsigned xb_add(unsigned* p, unsigned v) { return __hip_atomic_fetch_add(p, v, __ATOMIC_RELAXED, __HIP_MEMORY_SCOPE_AGENT); }
__device__ __forceinline__ unsigned xb_xcc_id() { return (unsigned)__builtin_amdgcn_s_getreg((3 << 11) | 20) & 0xFu; }
#define XB_SPIN(cond, bar) do { unsigned _sp = 0; while (cond) { __builtin_amdgcn_s_sleep(1); \
    if ((++_sp & 255u) == 0u) { if (xb_ld(&(bar)[XB_TMO])) break; if (_sp > XB_SPIN_CAP) { atomicAdd(&(bar)[XB_TMO], 1u); break; } } } } while (0)
struct XcdBarrier { unsigned* bar; unsigned x; volatile LAS unsigned* st; };
__device__ __forceinline__ XcdBarrier xcd_barrier_post(unsigned* bar, volatile LAS unsigned* st) {
    XcdBarrier b; b.bar = bar; b.x = xb_xcc_id(); b.st = st;
    if (threadIdx.x == 0) (void)xb_add(&bar[XB_XCNT(b.x)], 1u);
    return b;
}
__device__ __forceinline__ void xcd_barrier_complete(unsigned* bar, unsigned x, unsigned& nloc, unsigned& nx) {
    const unsigned G = gridDim.x * gridDim.y * gridDim.z;
    unsigned sum, cnt, mine, sp = 0u;
    for (;;) {
        sum = 0u; cnt = 0u; mine = 0u;
#pragma unroll
        for (unsigned j = 0; j < 16; ++j) { const unsigned c = xb_ld(&bar[XB_XCNT(j)]); sum += c; cnt += (c > 0u) ? 1u : 0u; mine = (j == x) ? c : mine; }
        if (sum == G) break;
        __builtin_amdgcn_s_sleep(1);
        if ((++sp & 255u) == 0u) { if (xb_ld(&bar[XB_TMO])) break; if (sp > XB_SPIN_CAP) { atomicAdd(&bar[XB_TMO], 1u); break; } }
    }
    nloc = mine > 0u ? mine : 1u; nx = cnt > 0u ? cnt : 1u;
}
__device__ __forceinline__ void xcd_barrier(const XcdBarrier& b) {
    asm volatile("s_waitcnt vmcnt(0)" ::: "memory");
    __syncthreads();
    if (threadIdx.x == 0) {
        unsigned* bar = b.bar;
        __builtin_amdgcn_s_waitcnt(0);
        unsigned nloc = b.st[0], nx = b.st[1];
        if (nloc == 0u) { xcd_barrier_complete(bar, b.x, nloc, nx); b.st[0] = nloc; b.st[1] = nx; }
        const unsigned old = xb_add(&bar[XB_XSUB(b.x)], 1u);
        const unsigned gen = old / nloc;
        if (old + 1u == (gen + 1u) * nloc) {
            __builtin_amdgcn_fence(__ATOMIC_RELEASE, "agent");
            asm volatile("s_waitcnt vmcnt(0)" ::: "memory");
            const unsigned og = xb_add(&bar[XB_TOP], 1u);
            const unsigned tg = og / nx;
            if (og + 1u == (tg + 1u) * nx) xb_add(&bar[XB_TOPGEN], 1u);
            else XB_SPIN(xb_ld(&bar[XB_TOPGEN]) == tg, bar);
            __builtin_amdgcn_fence(__ATOMIC_ACQUIRE, "agent");
            xb_add(&bar[XB_XGEN(b.x)], 1u);
            asm volatile("s_waitcnt vmcnt(0)" ::: "memory");
        } else {
            XB_SPIN(xb_ld(&bar[XB_XGEN(b.x)]) == gen, bar);
            __builtin_amdgcn_fence(__ATOMIC_ACQUIRE, "agent");
            asm volatile("s_waitcnt vmcnt(0)" ::: "memory");
        }
    }
    __syncthreads();
}

struct Args { const float* in[24]; float* out; unsigned char* ws; int ph_lo, ph_hi; };
struct Frame {
    LAS unsigned char* lds; unsigned char* lds_gen; volatile LAS unsigned* MISC; unsigned* ctl;
    int tid, lane, wave, G, vcu;
    unsigned char* ws; float* X;
};
__device__ __forceinline__ void p0_item(const float* W, int ldw, int c0, int k0, bf16* WT, int Kd, int drow, int drow2, const float* kscale, LAS float* scr, int lane) {
    const int nq = lane & 7, kr = lane >> 3; f32x4 v[2][8];
#pragma unroll
    for (int hf = 0; hf < 2; ++hf)
#pragma unroll
        for (int i = 0; i < 8; ++i) v[hf][i] = *(const f32x4*)(W + (size_t)(k0 + kr + 8 * i) * ldw + c0 + 32 * hf + 4 * nq);
    if (kscale) {
#pragma unroll
        for (int i = 0; i < 8; ++i) { const float sc = kscale[k0 + kr + 8 * i]; v[0][i] = v[0][i] * sc; v[1][i] = v[1][i] * sc; } }
    const int c = lane & 7;
#pragma unroll
    for (int hf = 0; hf < 2; ++hf) {
#pragma unroll
        for (int i = 0; i < 8; ++i)
#pragma unroll
            for (int e = 0; e < 4; ++e) scr[(kr + 8 * i) * 33 + 4 * nq + e] = v[hf][i][e];
        LDS_WAIT(); asm volatile("" ::: "memory");
        const int dr = hf ? drow2 : drow;
#pragma unroll
        for (int j = 0; j < 4; ++j) { const int n = (lane >> 3) + 8 * j; const LAS float* s = scr + (8 * c) * 33 + n;
            v4u o; o.x = pk2(s[0 * 33], s[1 * 33]); o.y = pk2(s[2 * 33], s[3 * 33]); o.z = pk2(s[4 * 33], s[5 * 33]); o.w = pk2(s[6 * 33], s[7 * 33]);
            *(v4u*)(WT + (size_t)(dr + n) * Kd + k0 + 8 * c) = o; }
        LDS_WAIT(); asm volatile("" ::: "memory");
    }
}
constexpr int PTAB_OFF = LDSCTL_OFF + 1024;
struct Ptrs {
    volatile LAS unsigned* tab; unsigned char* ws;
    __device__ __forceinline__ const float* in(int i) const { const unsigned lo = __builtin_amdgcn_readfirstlane(tab[2 * i]), hi = __builtin_amdgcn_readfirstlane(tab[2 * i + 1]); return (const float*)(const GAS float*)(((unsigned long long)hi << 32) | lo); }
    __device__ __forceinline__ const float* x() const { return in(0); }
    __device__ __forceinline__ const float* ln_in_g() const { return in(1); }
    __device__ __forceinline__ const float* ln_in_b() const { return in(2); }
    __device__ __forceinline__ const float* w_in() const { return in(3); }
    __device__ __forceinline__ const float* b_f() const { return in(4); }
    __device__ __forceinline__ const float* conv_w() const { return in(5); }
    __device__ __forceinline__ const float* conv_b() const { return in(6); }
    __device__ __forceinline__ const float* sgu_ln_g() const { return in(7); }
    __device__ __forceinline__ const float* sgu_ln_b() const { return in(8); }
    __device__ __forceinline__ const float* sgu_w() const { return in(9); }
    __device__ __forceinline__ const float* sgu_b() const { return in(10); }
    __device__ __forceinline__ const float* grp_g() const { return in(11); }
    __device__ __forceinline__ const float* w_out() const { return in(12); }
    __device__ __forceinline__ const float* ln1_g() const { return in(13); }
    __device__ __forceinline__ const float* ln1_b() const { return in(14); }
    __device__ __forceinline__ const float* rgw() const { return in(15); }
    __device__ __forceinline__ const float* rgb() const { return in(16); }
    __device__ __forceinline__ const float* rew() const { return in(17); }
    __device__ __forceinline__ const float* reb() const { return in(18); }
    __device__ __forceinline__ const float* w1() const { return in(19); }
    __device__ __forceinline__ const float* w3() const { return in(20); }
    __device__ __forceinline__ const float* w2() const { return in(21); }
    __device__ __forceinline__ const float* ln2_g() const { return in(22); }
    __device__ __forceinline__ const float* ln2_b() const { return in(23); }
    __device__ __forceinline__ float* LF() const { return (float*)(ws + WS_LF); }
    __device__ __forceinline__ float* C2G() const { return (float*)(ws + WS_C2); }
    __device__ __forceinline__ float* GL() const { return (float*)(ws + WS_GL); }
    __device__ __forceinline__ float* SS() const { return (float*)(ws + WS_SS); }
    __device__ __forceinline__ float* TG() const { return (float*)(ws + WS_TG); }
    __device__ __forceinline__ int* TE() const { return (int*)(ws + WS_TE); }
    __device__ __forceinline__ int* TS() const { return (int*)(ws + WS_TS); }
    __device__ __forceinline__ int* RT() const { return (int*)(ws + WS_RT); }
    __device__ __forceinline__ bf16* RW() const { return (bf16*)(ws + WS_RW); }
    __device__ __forceinline__ bf16* SGW() const { return (bf16*)(ws + WS_SGW); }
    __device__ __forceinline__ bf16* WIN() const { return (bf16*)(ws + WS_WIN); }
    __device__ __forceinline__ bf16* WOUT() const { return (bf16*)(ws + WS_WOUT); }
    __device__ __forceinline__ bf16* W13() const { return (bf16*)(ws + WS_W13); }
    __device__ __forceinline__ bf16* W2() const { return (bf16*)(ws + WS_W2); }
    __device__ __forceinline__ bf16* XN() const { return (bf16*)(ws + WS_XN); }
    __device__ __forceinline__ bf16* MIX() const { return (bf16*)(ws + WS_MIX); }
    __device__ __forceinline__ bf16* PROJ() const { return (bf16*)(ws + WS_PROJ); }
    __device__ __forceinline__ bf16* MOUT() const { return (bf16*)(ws + WS_PROJ); }
    __device__ __forceinline__ bf16* O() const { return (bf16*)(ws + WS_PROJ); }
    __device__ __forceinline__ bf16* H() const { return (bf16*)(ws + WS_H); }
};
__device__ __forceinline__ int win_src_col(int n0) {
    if (n0 < 1536) return n0;
    if (n0 >= 2304) return n0 + 4;
    const int t = n0 - 1536, tile = t >> 8, off = t & 255;
    if (tile == 2) return 1540 + 256 + off;
    return (off < 128) ? 1540 + 128 * tile + off : 1540 + 512 + 128 * tile + (off - 128);
}
__device__ __forceinline__ void p0_weights(Frame& F, const Ptrs& P) {
    LAS float* scr = (LAS float*)(F.lds + F.wave * 16384);
    const int gw = F.vcu * 8 + F.wave, NGW = F.G * 8;
    constexpr int I_IN = 16 * 44, I_OUT = 16 * 16, PER_L = I_IN + I_OUT;
    for (int it = gw; it < NL * PER_L; it += NGW) {
        const int l = it / PER_L; int r = it % PER_L;
        if (r < I_IN) { const int kb = r / 44, nb = r % 44, n0 = 64 * nb; p0_item(P.w_in() + (size_t)l * D * PWIN, PWIN, win_src_col(n0), 64 * kb, P.WIN() + (size_t)l * NPROJ * D, D, n0, n0 + 32, nullptr, scr, F.lane); continue; } r -= I_IN;
        { const int kb = r / 16, nb = r % 16; p0_item(P.w_out() + (size_t)l * D * D, D, 64 * nb, 64 * kb, P.WOUT() + (size_t)l * D * D, D, 64 * nb, 64 * nb + 32, P.grp_g() + l * D, scr, F.lane); }
    }
    const int gt = F.vcu * 512 + F.tid, NGT = F.G * 512;
    for (int i = gt; i < NL * 2 * 64 * 64 * 8; i += NGT) { const int j = i & 7, ln = (i >> 3) & 63, s = (i >> 9) & 63, blk = (i >> 15) & 1, l = i >> 16;
        const int row = 32 * blk + (ln & 31), k = 16 * s + 8 * (ln >> 5) + j;
        float v = 0.f; if (row < 32) v = P.rew()[((size_t)l * D + k) * 32 + row]; else if (row < 36) v = P.rgw()[((size_t)l * D + k) * 4 + (row - 32)];
        P.RW()[i] = (bf16)f2bf(v); }
    for (int i = gt; i < NL * NH * 128 * 128; i += NGT) { const int jj = i & 7, ln = (i >> 3) & 63, ib = (i >> 9) & 1, ks = (i >> 10) & 7, ih = (i >> 13) & 1, lg = i >> 14;
        const int ii = 64 * ih + 32 * ib + (ln & 31), j = 16 * ks + 8 * (jj >> 2) + 4 * (ln >> 5) + (jj & 3);
        const float v = ((j >> 6) <= (ii >> 6)) ? P.sgu_w()[((size_t)lg * 128 + ii) * 128 + j] : 0.f; P.SGW()[i] = (bf16)f2bf(v); }
}

struct WfRegs { f32x4 w[4][4]; };
__device__ __forceinline__ void load_wf(WfRegs& R, const float* w_in_l, int lane, int ld = PWIN, int col = 1536) {
#pragma unroll
    for (int j = 0; j < 4; ++j)
#pragma unroll
        for (int i = 0; i < 4; ++i) R.w[j][i] = *(const f32x4*)(w_in_l + (size_t)(4 * lane + 256 * j + i) * ld + col);
}
__device__ __forceinline__ void load_gb(f32x4 (&gr)[4], f32x4 (&br)[4], const float* g, const float* b, int lane) {
#pragma unroll
    for (int j = 0; j < 4; ++j) { gr[j] = *(const f32x4*)(g + 4 * lane + 256 * j); br[j] = *(const f32x4*)(b + 4 * lane + 256 * j); }
}
template <int LFL, bool WF32, bool WBF = true>
__device__ __forceinline__ void finish_row(f32x4 (&v)[4], const f32x4 (&gr)[4], const f32x4 (&br)[4], float* xrow, bf16* xnrow, const WfRegs& R, const f32x4 bf, float* lfrow, int lane) {
    float s = 0.f;
#pragma unroll
    for (int j = 0; j < 4; ++j) s += (v[j].x + v[j].y) + (v[j].z + v[j].w);
    const float mean = wave_sum(s) * (1.f / D); float s2 = 0.f;
#pragma unroll
    for (int j = 0; j < 4; ++j) { v[j] = v[j] - mean; s2 += (v[j].x * v[j].x + v[j].y * v[j].y) + (v[j].z * v[j].z + v[j].w * v[j].w); }
    const float rstd = rsqrtf(wave_sum(s2) * (1.f / D) + LN_EPS);
    f32x4 dots = {0.f, 0.f, 0.f, 0.f};
#pragma unroll
    for (int j = 0; j < 4; ++j) {
        const f32x4 y = v[j] * rstd * gr[j] + br[j];
        if (WF32) *(f32x4*)(xrow + 4 * lane + 256 * j) = y;
        if (WBF) { v2u o; o.x = pk2(y.x, y.y); o.y = pk2(y.z, y.w); *(v2u*)(xnrow + 4 * lane + 256 * j) = o; }
        if (LFL) dots = dots + R.w[j][0] * y.x + R.w[j][1] * y.y + R.w[j][2] * y.z + R.w[j][3] * y.w; }
    if (LFL) {
        const float d0 = wave_sum(dots.x), d1 = wave_sum(dots.y), d2 = wave_sum(dots.z), d3 = wave_sum(dots.w);
        if (lane == 0) { f32x4 o; if (LFL == 1) { o.x = log_sigmoid_f(d0 + bf[0]); o.y = log_sigmoid_f(d1 + bf[1]); o.z = log_sigmoid_f(d2 + bf[2]); o.w = log_sigmoid_f(d3 + bf[3]); } else { o.x = d0 + bf[0]; o.y = d1 + bf[1]; o.z = d2 + bf[2]; o.w = d3 + bf[3]; } *(f32x4*)lfrow = o; }
    }
}
__device__ __forceinline__ void p0_rows(Frame& F, const Ptrs& P) {
    WfRegs R; load_wf(R, P.w_in(), F.lane);
    const int gw = F.vcu * 8 + F.wave, NGW = F.G * 8;
    const float* x = P.x(); const f32x4 bf = *(const f32x4*)P.b_f(); bf16* XN = P.XN(); float* LF = P.LF();
    f32x4 lg[4], lb[4]; load_gb(lg, lb, P.ln_in_g(), P.ln_in_b(), F.lane);
    f32x4 cur[4], nxt[4];
    if (gw < T) {
#pragma unroll
        for (int j = 0; j < 4; ++j) cur[j] = *(const f32x4*)(x + (size_t)gw * D + 4 * F.lane + 256 * j); }
    for (int m = gw; m < T; m += NGW) {
        const int mn = m + NGW;
        if (mn < T) {
#pragma unroll
            for (int j = 0; j < 4; ++j) nxt[j] = *(const f32x4*)(x + (size_t)mn * D + 4 * F.lane + 256 * j); }
        finish_row<1, false>(cur, lg, lb, nullptr, XN + (size_t)m * D, R, bf, LF + (size_t)m * 4, F.lane);
#pragma unroll
        for (int j = 0; j < 4; ++j) cur[j] = nxt[j];
    }
}
__device__ __forceinline__ void c2_scan(Frame& F, const Ptrs& P, int bh) {
    const int tid = F.tid, lane = F.lane, w = F.wave; LAS float* red = (LAS float*)(F.lds);
    const size_t row0 = (size_t)(bh >> 2) * S; const int h = bh & 3;
    float a[4];
#pragma unroll
    for (int i = 0; i < 4; ++i) a[i] = P.LF()[(row0 + 4 * tid + i) * 4 + h] * LOG2E;
    a[1] += a[0]; a[2] += a[1]; a[3] += a[2];
    float run = a[3];
#pragma unroll
    for (int o = 1; o < 64; o <<= 1) { const float t = __shfl_up(run, o); if (lane >= o) run += t; }
    if (lane == 63) red[w] = run;
    __syncthreads();
    float base = run - a[3];
    for (int i = 0; i < w; ++i) base += red[i];
    f32x4 o; o.x = base + a[0]; o.y = base + a[1]; o.z = base + a[2]; o.w = base + a[3];
    *(f32x4*)(P.C2G() + (size_t)bh * S + 4 * tid) = o;
    __syncthreads();
}

typedef short v4i16_t __attribute__((ext_vector_type(4)));
__device__ __forceinline__ s16x4 vtr(const LAS unsigned char* p) { return __builtin_bit_cast(s16x4, __builtin_amdgcn_ds_read_tr16_b64_v4i16((LAS v4i16_t*)p)); }
__device__ __forceinline__ int crow(int r, int hi) { return (r & 3) + 8 * (r >> 2) + 4 * hi; }
__device__ __forceinline__ bf16x8 pack8(const f32x16& p, int b0) {
    v4u w; w.x = pk2(p[b0], p[b0 + 1]); w.y = pk2(p[b0 + 2], p[b0 + 3]); w.z = pk2(p[b0 + 4], p[b0 + 5]); w.w = pk2(p[b0 + 6], p[b0 + 7]); return __builtin_bit_cast(bf16x8, w);
}
constexpr int AT_K = 0, AT_V = 16384, AT_C = 32768, AT_RED = 40960;

template <bool STICK, bool DIAG, int MODE = 0>
__device__ __forceinline__ void attn_tile(const LAS unsigned char* Kb, const LAS unsigned char* Vb, const int (&kra)[4], const int vp0, const bf16x8 (&qr)[4],
                                          const LAS float* CBt, f32x16& cbase, const int qrel_, const int hh, f32x16 (&o)[2], float& m_run, float& l_run, float& Rp) {
    if (MODE == 3) return;
    int qrel = qrel_; if (DIAG) asm volatile("" : "+v"(qrel));
    bf16x8 kf[2][4];
#pragma unroll
    for (int kb = 0; kb < 2; ++kb)
#pragma unroll
        for (int ks = 0; ks < 4; ++ks) kf[kb][ks] = (MODE == 4) ? qr[(ks + kb) & 3] : *(const LAS bf16x8*)(Kb + kra[ks] + kb * 4096);
    f32x16 sc[2];
#pragma unroll
    for (int kb = 0; kb < 2; ++kb) { f32x16 a = STICK ? f32x16{} : cbase;
#pragma unroll
        for (int ks = 0; ks < 4; ++ks) a = __builtin_amdgcn_mfma_f32_32x32x16_bf16(kf[kb][ks], qr[ks], a, 0, 0, 0);
        sc[kb] = a; }
    s16x4 vlo[4], vhi[4];
#pragma unroll
    for (int ks = 0; ks < 4; ++ks) { if (MODE == 5) { vlo[ks] = __builtin_bit_cast(s16x4, (v2u){(unsigned)qr[ks][0], (unsigned)qr[ks][1]}); vhi[ks] = vlo[ks]; } else { vlo[ks] = vtr(Vb + vp0 + ks * 1024); vhi[ks] = vtr(Vb + vp0 + ks * 1024 + 512); } }
    if (MODE == 1) {
#pragma unroll
        for (int i = 0; i < 16; ++i) { sc[0][i] *= 0.001f; sc[1][i] *= 0.001f; }
    } else if (!STICK) {
#pragma unroll
        for (int kb = 0; kb < 2; ++kb)
#pragma unroll
            for (int g4 = 0; g4 < 4; ++g4) { const f32x4 ncs = *(const LAS f32x4*)(CBt + 32 * kb + 8 * g4 + 4 * hh);
                f32x2 a = {sc[kb][4 * g4], sc[kb][4 * g4 + 1]}, c = {sc[kb][4 * g4 + 2], sc[kb][4 * g4 + 3]};
                a = a + (f32x2){ncs.x, ncs.y}; c = c + (f32x2){ncs.z, ncs.w};
                sc[kb][4 * g4] = a.x; sc[kb][4 * g4 + 1] = a.y; sc[kb][4 * g4 + 2] = c.x; sc[kb][4 * g4 + 3] = c.y;
                if (DIAG) {
#pragma unroll
                    for (int e = 0; e < 4; ++e) sc[kb][4 * g4 + e] = (32 * kb + 8 * g4 + 4 * hh + e > qrel) ? -1e30f : sc[kb][4 * g4 + e]; } }
        float m0 = fmaxf(fmaxf(sc[0][0], sc[0][1]), sc[0][2]), m1 = fmaxf(fmaxf(sc[1][0], sc[1][1]), sc[1][2]);
#pragma unroll
        for (int i = 3; i < 15; i += 2) { m0 = fmaxf(fmaxf(m0, sc[0][i]), sc[0][i + 1]); m1 = fmaxf(fmaxf(m1, sc[1][i]), sc[1][i + 1]); }
        float mx = fmaxf(fmaxf(m0, m1), fmaxf(sc[0][15], sc[1][15]));
        mx = fmaxf(mx, other_half(mx));
        if (__any(mx > 0.f)) {
            const float dl = fmaxf(mx, 0.f), alpha = __builtin_amdgcn_exp2f(-dl); m_run += dl; l_run *= alpha;
#pragma unroll
            for (int i = 0; i < 16; ++i) { o[0][i] *= alpha; o[1][i] *= alpha; sc[0][i] -= dl; sc[1][i] -= dl; cbase[i] -= dl; }
        }
        f32x2 ps2 = {0.f, 0.f};
#pragma unroll
        for (int kb = 0; kb < 2; ++kb)
#pragma unroll
            for (int i = 0; i < 16; i += 2) { f32x2 p = {__builtin_amdgcn_exp2f(sc[kb][i]), __builtin_amdgcn_exp2f(sc[kb][i + 1])}; sc[kb][i] = p.x; sc[kb][i + 1] = p.y; ps2 = ps2 + p; }
        l_run += ps2.x + ps2.y;
    } else {
#pragma unroll
        for (int kb = 1; kb >= 0; --kb) {
            float om[16], be[16];
#pragma unroll
            for (int i = 0; i < 16; ++i) { const float e = __builtin_amdgcn_exp2f(sc[kb][i]); float t = __builtin_amdgcn_rcpf(1.0f + e);
                if (DIAG) t = (32 * kb + crow(i, 0) + 4 * hh >= qrel) ? 1.0f : t;
                om[i] = t; be[i] = 1.0f - t; }
            float se[16], gp[4], pr[4], og[4];
#pragma unroll
            for (int g4 = 0; g4 < 4; ++g4) { se[4 * g4 + 3] = 1.0f; se[4 * g4 + 2] = om[4 * g4 + 3]; se[4 * g4 + 1] = se[4 * g4 + 2] * om[4 * g4 + 2]; se[4 * g4] = se[4 * g4 + 1] * om[4 * g4 + 1]; gp[g4] = se[4 * g4] * om[4 * g4];
                og[g4] = other_half(gp[g4]); pr[g4] = gp[g4] * og[g4]; }
            float later = Rp;
#pragma unroll
            for (int g4 = 3; g4 >= 0; --g4) { const float fac = later * (hh ? 1.0f : og[g4]);
#pragma unroll
                for (int e = 0; e < 4; ++e) sc[kb][4 * g4 + e] = be[4 * g4 + e] * se[4 * g4 + e] * fac;
                later *= pr[g4]; }
            Rp = later;
        }
    }
    bf16x8 pf[4]; pf[0] = pack8(sc[0], 0); pf[1] = pack8(sc[0], 8); pf[2] = pack8(sc[1], 0); pf[3] = pack8(sc[1], 8);
    if (MODE == 2) { o[0][0] += __builtin_bit_cast(v4u, pf[0]).x + __builtin_bit_cast(v4u, pf[1]).x + __builtin_bit_cast(v4u, pf[2]).x + __builtin_bit_cast(v4u, pf[3]).x + vlo[0][0] + vhi[3][0]; return; }
    s16x4 wlo[4], whi[4];
#pragma unroll
    for (int ks = 0; ks < 4; ++ks) { if (MODE == 5) { wlo[ks] = vlo[ks]; whi[ks] = vhi[ks]; } else { wlo[ks] = vtr(Vb + vp0 + 4096 + ks * 1024); whi[ks] = vtr(Vb + vp0 + 4096 + ks * 1024 + 512); } }
#pragma unroll
    for (int ks = 0; ks < 4; ++ks) { const bf16x8 vf = (bf16x8){vlo[ks][0], vlo[ks][1], vlo[ks][2], vlo[ks][3], vhi[ks][0], vhi[ks][1], vhi[ks][2], vhi[ks][3]};
        o[0] = __builtin_amdgcn_mfma_f32_32x32x16_bf16(vf, pf[ks], o[0], 0, 0, 0); }
#pragma unroll
    for (int ks = 0; ks < 4; ++ks) { const bf16x8 vf = (bf16x8){wlo[ks][0], wlo[ks][1], wlo[ks][2], wlo[ks][3], whi[ks][0], whi[ks][1], whi[ks][2], whi[ks][3]};
        o[1] = __builtin_amdgcn_mfma_f32_32x32x16_bf16(vf, pf[ks], o[1], 0, 0, 0); }
}

constexpr int AT_CB = LDSCTL_OFF + 4096;
template <bool STICK, int MODE = 0>
__device__ __forceinline__ void attn_unit(Frame& F, const Ptrs& P, int layer, int b, int h, int qb) {
    const int tid = F.tid, lane = F.lane, w = F.wave, r = lane & 31, hh = lane >> 5;
    const int qcol = (STICK ? 0 : 768) + h * HD, kcol = qcol + 256, vcol = qcol + 512, ocol = (STICK ? 0 : 256) + h * HD;
    const size_t row0 = (size_t)b * S;
    LAS unsigned char* lds = F.lds;
    const int skrow = 8 * w + (lane >> 3);
    const bf16* ksrc = P.PROJ() + (row0 + skrow) * NPROJ + kcol + 8 * ((lane & 7) ^ ((skrow >> 1) & 7));
    const bf16* vsrc = P.PROJ() + (row0 + 16 * (w & 3) + (lane >> 2)) * NPROJ + vcol + 32 * ((w >> 2) & 1) + 8 * (lane & 3);
#define ATT_STAGE(c_, bsel_) do { const size_t co_ = (size_t)(c_) * 256 * NPROJ; _Pragma("unroll") for (int j_ = 0; j_ < 4; ++j_) { \
        __builtin_amdgcn_global_load_lds((const unsigned*)(ksrc + co_ + (size_t)j_ * 64 * NPROJ), (LAS unsigned*)(lds + (bsel_) * 65536 + (64 * j_ + 8 * w) * 128), 16, 0, 0); \
        __builtin_amdgcn_global_load_lds((const unsigned*)(vsrc + co_ + (size_t)j_ * 64 * NPROJ), (LAS unsigned*)(lds + (bsel_) * 65536 + 32768 + (8 * j_ + w) * 1024), 16, 0, 0); } } while (0)
    ATT_STAGE(qb, 0);
    __builtin_amdgcn_sched_barrier(0);
    LAS float* CB = (LAS float*)(lds + AT_CB);
    if (!STICK) { if (tid < 64 * (qb + 1)) *(LAS f32x4*)(CB + 4 * tid) = -*(const f32x4*)(P.C2G() + (size_t)(b * NH + h) * S + 4 * tid); }
    const int qrow = 256 * qb + 32 * w + r;
    bf16x8 qr[4];
#pragma unroll
    for (int ks = 0; ks < 4; ++ks) qr[ks] = *(const bf16x8*)(P.PROJ() + (row0 + qrow) * NPROJ + qcol + 16 * ks + 8 * hh);
    const int my_hi = 4 * qb + (w >> 1), qrel = 32 * (w & 1) + r;
    float zb = 0.f;
    if (!STICK) { float s2 = 0.f;
#pragma unroll
        for (int ks = 0; ks < 4; ++ks) { const v4u qq = __builtin_bit_cast(v4u, qr[ks]);
            s2 += (bflo(qq.x) * bflo(qq.x) + bfhi(qq.x) * bfhi(qq.x)) + (bflo(qq.y) * bflo(qq.y) + bfhi(qq.y) * bfhi(qq.y)) + (bflo(qq.z) * bflo(qq.z) + bfhi(qq.z) * bfhi(qq.z)) + (bflo(qq.w) * bflo(qq.w) + bfhi(qq.w) * bfhi(qq.w)); }
        s2 += other_half(s2);
        const unsigned* kw = F.ctl + CW_KINF + 128 * layer + (b * 4 + h) * 2;
        const float k2 = __uint_as_float(__hip_atomic_load(kw, RLX_AGENT)) + __uint_as_float(__hip_atomic_load(kw + 1, RLX_AGENT));
        zb = sqrtf(s2 * k2) * 1.01f; }
    const int vp0 = ((lane >> 4) & 1) * 32 + (lane & 3) * 8 + (4 * hh + ((lane & 15) >> 2)) * 64;
    int kra[4];
#pragma unroll
    for (int ks = 0; ks < 4; ++ks) kra[ks] = r * 128 + (((2 * ks + hh) ^ ((r >> 1) & 7)) * 16);
    f32x16 o[2]; o[0] = f32x16{}; o[1] = f32x16{};
    float m_run = 0.f, l_run = 0.f, Rp = 1.0f, ct2 = 0.f;
    asm volatile("s_waitcnt vmcnt(0)" ::: "memory");
    __syncthreads();
    if (!STICK) ct2 = -CB[qrow];
    f32x16 cbase;
#pragma unroll
    for (int i = 0; i < 16; ++i) cbase[i] = ct2;
    int buf = 0; bool wdone = false;
    for (int c = qb; c >= 0; --c) {
        if (c > 0) ATT_STAGE(c - 1, buf ^ 1);
#pragma nounroll
        for (int t4 = 3; t4 >= 0; --t4) { const int kt = 4 * c + t4;
            if (kt <= my_hi && !wdone) { const LAS unsigned char* Kb = lds + buf * 65536 + t4 * 8192; const LAS unsigned char* Vb = Kb + 32768;
                if (kt == my_hi) attn_tile<STICK, true, MODE>(Kb, Vb, kra, vp0, qr, CB + 64 * kt, cbase, qrel, hh, o, m_run, l_run, Rp);
                else attn_tile<STICK, false, MODE>(Kb, Vb, kra, vp0, qr, CB + 64 * kt, cbase, qrel, hh, o, m_run, l_run, Rp);
                wdone = STICK ? __all(Rp < 1e-14f) : (kt > 0 && __all(zb + ct2 + CB[64 * kt - 1] - m_run < -48.f)); } }
        if (lane == 0) F.MISC[16 + 8 * (c & 1) + w] = wdone ? 1u : 0u;
        asm volatile("s_waitcnt vmcnt(0)" ::: "memory");
        __syncthreads();
        buf ^= 1;
        unsigned all_ = 1u;
#pragma unroll
        for (int i_ = 0; i_ < 8; ++i_) all_ &= F.MISC[16 + 8 * (c & 1) + i_];
        if (all_) break;
    }
#undef ATT_STAGE
    float inv = 1.0f;
    if (!STICK) { const float lt = l_run + other_half(l_run); inv = 1.0f / lt; }
    float ss = 0.f;
#pragma unroll
    for (int dh = 0; dh < 2; ++dh)
#pragma unroll
        for (int i = 0; i < 16; ++i) { o[dh][i] *= inv; ss += o[dh][i] * o[dh][i]; }
    ss += other_half(ss);
    const size_t tok = row0 + qrow;
    if (hh == 0) P.SS()[tok * 8 + (STICK ? 0 : 4) + h] = ss;
    LAS unsigned char* stg = lds + w * 4608;
#pragma unroll
    for (int dh = 0; dh < 2; ++dh)
#pragma unroll
        for (int g4 = 0; g4 < 4; ++g4) { v2u ov; ov.x = pk2(o[dh][4 * g4], o[dh][4 * g4 + 1]); ov.y = pk2(o[dh][4 * g4 + 2], o[dh][4 * g4 + 3]); *(LAS v2u*)(stg + r * 144 + (32 * dh + 8 * g4 + 4 * hh) * 2) = ov; }
    LDS_WAIT();
    bf16* ob = P.MIX() + (row0 + 256 * qb + 32 * w) * D + ocol;
#pragma unroll
    for (int i = 0; i < 4; ++i) { const int row = 8 * i + (lane >> 3), ch = lane & 7; const v4u v = *(const LAS v4u*)(stg + row * 144 + ch * 16); *(v4u*)(ob + (size_t)row * D + 8 * ch) = v; }
}

__device__ __forceinline__ f32x4 ld4bf(const bf16* p) { const v2u q = *(const v2u*)p; return (f32x4){bflo(q.x), bfhi(q.x), bflo(q.y), bfhi(q.y)}; }
#define UNP(q) ((f32x4){bflo((q).x), bfhi((q).x), bflo((q).y), bfhi((q).y)})
__device__ __forceinline__ void conv_unit(Frame& F, const Ptrs& P, int layer, int cu) {
    const int lane = F.lane, c = 4 * lane;
    const float* cw = P.conv_w() + (size_t)layer * 3 * GW; const f32x4 w0 = *(const f32x4*)(cw + c), w1 = *(const f32x4*)(cw + GW + c), w2 = *(const f32x4*)(cw + 2 * GW + c), cb = *(const f32x4*)(P.conv_b() + (size_t)layer * GW + c);
    const int tok0 = cu * 128 + F.wave * 16, t0 = tok0 % S;
    const char* ub = (const char*)(P.PROJ() + (size_t)tok0 * NPROJ); char* mb = (char*)(P.MIX() + (size_t)tok0 * D + 512); const unsigned lo = 8u * (unsigned)lane;
#define CLD(i, col) (*(const v2u*)(ub + (ptrdiff_t)(i) * (NPROJ * 2) + (col) * 2 + lo))
    f32x4 z2 = {0.f, 0.f, 0.f, 0.f}, z1 = {0.f, 0.f, 0.f, 0.f};
    if (t0 >= 2) { z2 = UNP(CLD(-2, 1536)); z1 = UNP(CLD(-1, 1536)); }
#pragma unroll
    for (int hf = 0; hf < 2; ++hf) {
        v2u zq[8], bq[8];
#pragma unroll
        for (int i = 0; i < 8; ++i) { zq[i] = CLD(8 * hf + i, 1536); bq[i] = CLD(8 * hf + i, 2048); }
#pragma unroll
        for (int i = 0; i < 8; ++i) {
            const f32x4 z0 = UNP(zq[i]), bg = UNP(bq[i]);
            const f32x4 y = bg * (cb + w0 * z2 + w1 * z1 + w2 * z0);
            const float q = wave_sum((y.x * y.x + y.y * y.y) + (y.z * y.z + y.w * y.w));
            const float rs = rsqrtf(q * (1.f / GW) + RMS_EPS);
            v2u o; o.x = pk2(y.x * rs, y.y * rs); o.y = pk2(y.z * rs, y.w * rs); *(v2u*)(mb + (size_t)(8 * hf + i) * (D * 2) + lo) = o;
            z2 = z1; z1 = z0; }
    }
#undef CLD
}

constexpr int SG_VL = 0, SG_US = 65536, SG_SSQ = LDSCTL_OFF + 4096;
template <int MODE = 0>
__device__ __forceinline__ void sgu_unit(Frame& F, const Ptrs& P, int layer, int su) {
    const int lane = F.lane, w = F.wave, r = lane & 31, hh = lane >> 5;
    const size_t base = (size_t)su * 128;
    LAS unsigned char* lds = F.lds;
    const int g = w >> 1, ih = w & 1;
    const bf16* wgf = P.SGW() + ((size_t)((layer * NH + g) * 2 + ih) * 8) * 2 * 512 + lane * 8;
    v4u wq[8][2]; v4u ut[8]; float bsv[2];
    const int urow = lane >> 3, uch = lane & 7;
    const bf16* up = P.PROJ() + (base + 64 * ih + urow) * NPROJ + 2304 + 64 * g + 8 * uch;
    LAS unsigned char* ust = lds + SG_US + w * 8192;
    {
        const int c = 4 * lane; const f32x4 gg = *(const f32x4*)(P.sgu_ln_g() + (size_t)layer * GW + c), bb = *(const f32x4*)(P.sgu_ln_b() + (size_t)layer * GW + c);
        const bf16* vp = P.PROJ() + (base + 16 * w) * NPROJ + 2560 + c; v2u vq[16];
#pragma unroll
        for (int i = 0; i < 16; ++i) vq[i] = *(const v2u*)(vp + (size_t)i * NPROJ);
#pragma unroll
        for (int ks = 0; ks < 8; ++ks) { if (ks < 4 || ih) { wq[ks][0] = *(const v4u*)(wgf + (ks * 2 + 0) * 512); wq[ks][1] = *(const v4u*)(wgf + (ks * 2 + 1) * 512); } }
#pragma unroll
        for (int i = 0; i < 8; ++i) ut[i] = *(const v4u*)(up + (size_t)(8 * i) * NPROJ);
#pragma unroll
        for (int ib = 0; ib < 2; ++ib) bsv[ib] = P.sgu_b()[(size_t)(layer * NH + g) * 128 + 64 * ih + 32 * ib + r];
        __builtin_amdgcn_sched_barrier(0);
#pragma unroll
        for (int i = 0; i < 16; ++i) { const int j = 16 * w + i; f32x4 v = UNP(vq[i]);
            if (MODE == 12) { v2u o; o.x = pk2(v.x, v.y); o.y = pk2(v.z, v.w); *(LAS v2u*)(lds + SG_VL + (c >> 5) * 8192 + (j >> 4) * 1024 + (j & 15) * 64 + (c & 31) * 2) = o; continue; }
            const float mean = wave_sum((v.x + v.y) + (v.z + v.w)) * (1.f / GW); v = v - mean;
            const float rstd = rsqrtf(wave_sum((v.x * v.x + v.y * v.y) + (v.z * v.z + v.w * v.w)) * (1.f / GW) + LN_EPS);
            v = v * rstd * gg + bb; v2u o; o.x = pk2(v.x, v.y); o.y = pk2(v.z, v.w);
            *(LAS v2u*)(lds + SG_VL + (c >> 5) * 8192 + (j >> 4) * 1024 + (j & 15) * 64 + (c & 31) * 2) = o; }
#pragma unroll
        for (int i = 0; i < 8; ++i) { const int row = 8 * i + urow; *(LAS v4u*)(ust + row * 128 + ((uch ^ ((row >> 1) & 7)) * 16)) = ut[i]; }
    }
    __syncthreads();
    f32x16 acc[2][2]; acc[0][0] = f32x16{}; acc[0][1] = f32x16{}; acc[1][0] = f32x16{}; acc[1][1] = f32x16{};
    const int vp0 = ((lane >> 4) & 1) * 32 + (lane & 3) * 8 + (4 * hh + ((lane & 15) >> 2)) * 64;
#pragma unroll
    for (int ks = 0; ks < (MODE == 11 ? 0 : 8); ++ks) { if (ks < 4 || ih) {
        bf16x8 wf[2], vf[2];
#pragma unroll
        for (int ib = 0; ib < 2; ++ib) wf[ib] = __builtin_bit_cast(bf16x8, wq[ks][ib]);
#pragma unroll
        for (int cb = 0; cb < 2; ++cb) { const LAS unsigned char* vb = lds + SG_VL + (2 * g + cb) * 8192 + ks * 1024 + vp0; const s16x4 lo = vtr(vb), hi = vtr(vb + 512);
            vf[cb] = (bf16x8){lo[0], lo[1], lo[2], lo[3], hi[0], hi[1], hi[2], hi[3]}; }
#pragma unroll
        for (int cb = 0; cb < 2; ++cb)
#pragma unroll
            for (int ib = 0; ib < 2; ++ib) acc[cb][ib] = __builtin_amdgcn_mfma_f32_32x32x16_bf16(vf[cb], wf[ib], acc[cb][ib], 0, 0, 0);
    } }
    LAS float* SSQ = (LAS float*)(lds + SG_SSQ);
#pragma unroll
    for (int ib = 0; ib < 2; ++ib) { const int row = 32 * ib + r, i = 64 * ih + row; const float bs = bsv[ib]; float q = 0.f;
#pragma unroll
        for (int cb = 0; cb < 2; ++cb)
#pragma unroll
            for (int g4 = 0; g4 < 4; ++g4) { const v2u uq = *(const LAS v2u*)(ust + row * 128 + (((4 * cb + g4) ^ ((row >> 1) & 7)) * 16) + 8 * hh); const f32x4 uu = UNP(uq);
#pragma unroll
                for (int e = 0; e < 4; ++e) { const float t = uu[e] * (acc[cb][ib][4 * g4 + e] + bs); acc[cb][ib][4 * g4 + e] = t; q += t * t; } }
        q += other_half(q);
        if (hh == 0) SSQ[i * 4 + g] = q; }
    __syncthreads();
#pragma unroll
    for (int ib = 0; ib < 2; ++ib) { const int row = 32 * ib + r, i = 64 * ih + row; const f32x4 qq = *(const LAS f32x4*)(SSQ + i * 4);
        const float rs = rsqrtf(((qq.x + qq.y) + (qq.z + qq.w)) * (1.f / GW) + RMS_EPS);
#pragma unroll
        for (int cb = 0; cb < 2; ++cb)
#pragma unroll
            for (int g4 = 0; g4 < 4; ++g4) { v2u o; o.x = pk2(acc[cb][ib][4 * g4] * rs, acc[cb][ib][4 * g4 + 1] * rs); o.y = pk2(acc[cb][ib][4 * g4 + 2] * rs, acc[cb][ib][4 * g4 + 3] * rs);
                *(LAS v2u*)(ust + row * 128 + (((4 * cb + g4) ^ ((row >> 1) & 7)) * 16) + 8 * hh) = o; } }
    LDS_WAIT();
    bf16* ob = P.MIX() + (base + 64 * ih + urow) * D + 768 + 64 * g + 8 * uch;
#pragma unroll
    for (int i = 0; i < 8; ++i) { const int row = 8 * i + urow; const v4u v = *(const LAS v4u*)(ust + row * 128 + ((uch ^ ((row >> 1) & 7)) * 16)); if (MODE != 14) *(v4u*)(ob + (size_t)(8 * i) * D) = v; }
    __syncthreads();
}
#undef UNP

constexpr int MOE_ITEMS = NE * 192;
__device__ __forceinline__ void moe_cvt_item(Frame& F, const Ptrs& P, int l, int it) {
    LAS float* scr = (LAS float*)(F.lds + F.wave * 16384);
    const int e = it / 192; int r = it % 192;
    if (r < 128) { const int which = r >> 6, q = r & 63, kb = q >> 2, nb = q & 3, j0 = 64 * nb, dr = 256 * (j0 >> 7) + 128 * which + (j0 & 127);
        p0_item((which ? P.w3() : P.w1()) + ((size_t)l * NE + e) * D * DE, DE, j0, 64 * kb, P.W13() + ((size_t)l * NE + e) * 512 * D, D, dr, dr + 32, nullptr, scr, F.lane); }
    else { r -= 128; const int kb = r >> 4, nb = r & 15; p0_item(P.w2() + ((size_t)l * NE + e) * DE * D, D, 64 * nb, 64 * kb, P.W2() + ((size_t)l * NE + e) * D * DE, DE, 64 * nb, 64 * nb + 32, nullptr, scr, F.lane); }
}
__device__ __forceinline__ void moe_cvt_tail(Frame& F, const Ptrs& P, int l, int part) {
    const int nwg = (T / 256) * (NPROJ / 256), rem = nwg % F.G, c = (int)blockIdx.x;
    int idx, stride;
    if (rem == 0) { idx = c * 8 + F.wave; stride = F.G * 8; } else { if (c < rem) return; idx = (c - rem) * 8 + F.wave; stride = (F.G - rem) * 8; }
    const int per = (MOE_ITEMS + stride - 1) / stride, half = per / 2;
    for (int k = part ? half : 0; k < (part ? per : half); ++k) { const int it = idx + k * stride; if (it < MOE_ITEMS) moe_cvt_item(F, P, l, it); }
    __syncthreads();
}

template <int MODE = 0>
__device__ __forceinline__ void mixer_phase(Frame& F, const Ptrs& P, int layer, int qslot, int u_lo = 0, int u_hi = 1 << 30) {
    constexpr int NU_ATT = NB * 8 * NH, NU = 2 * NU_ATT + NB * 16 + T / 128;
    unsigned* head = F.ctl + CW_QUEUE + 64 * qslot;
    unsigned nxt = 0u;
    if (F.tid == 0) nxt = __hip_atomic_fetch_add(head, 1u, RLX_AGENT);
    for (;;) {
        if (F.tid == 0) F.MISC[0] = nxt;
        __syncthreads();
        const int u = (int)F.MISC[0] + u_lo;
        if (u >= NU || u >= u_hi) break;
        if (F.tid == 0) nxt = __hip_atomic_fetch_add(head, 1u, RLX_AGENT);
        asm volatile("" : "+v"(F.tid)); F.lane = F.tid & 63;
        { int v = u;
            if (u >= NU_ATT && u < NU_ATT + NB * 16) v = 2 * NU_ATT + (u - NU_ATT); else if (u >= NU_ATT + NB * 16 && u < 2 * NU_ATT + NB * 16) v = u - NB * 16;
            if (v < NU_ATT) { const int qb = 7 - v / 64, bh = v % 64; attn_unit<false, MODE>(F, P, layer, bh >> 2, bh & 3, qb); }
            else if (v < 2 * NU_ATT) { const int v2 = v - NU_ATT, qb = 7 - v2 / 64, bh = v2 % 64; attn_unit<true, MODE>(F, P, layer, bh >> 2, bh & 3, qb); }
            else if (v < 2 * NU_ATT + NB * 16) sgu_unit<(MODE >= 10 ? MODE : 0)>(F, P, layer, v - 2 * NU_ATT);
            else conv_unit(F, P, layer, v - 2 * NU_ATT - NB * 16); }
        __syncthreads();
    }
}
__device__ __forceinline__ void norm_phase(Frame& F, const Ptrs& P) {
    const int gw = F.vcu * 8 + F.wave, NGW = F.G * 8, lane = F.lane;
    const float* SS = P.SS(); bf16* MIX = P.MIX();
    f32x4 q, qn; v4u v, vn;
    if (gw < T) { q = *(const f32x4*)(SS + (size_t)gw * 8 + 4 * (lane >> 5)); v = *(const v4u*)(MIX + (size_t)gw * D + 8 * lane); }
    for (int m = gw; m < T; m += NGW) {
        const int mn = m + NGW;
        if (mn < T) { qn = *(const f32x4*)(SS + (size_t)mn * 8 + 4 * (lane >> 5)); vn = *(const v4u*)(MIX + (size_t)mn * D + 8 * lane); }
        const float rs = rsqrtf(((q.x + q.y) + (q.z + q.w)) * (1.f / GW) + RMS_EPS);
        v.x = pk2(bflo(v.x) * rs, bfhi(v.x) * rs); v.y = pk2(bflo(v.y) * rs, bfhi(v.y) * rs); v.z = pk2(bflo(v.z) * rs, bfhi(v.z) * rs); v.w = pk2(bflo(v.w) * rs, bfhi(v.w) * rs);
        *(v4u*)(MIX + (size_t)m * D + 8 * lane) = v;
        q = qn; v = vn;
    }
}
constexpr int LC_PSTART = 0, LC_CNT = 33;
template <int MODE = 0>
__device__ __forceinline__ void router_phase(Frame& F, const Ptrs& P, int layer, int cslot) {
    const int lane = F.lane, w = F.wave, r = lane & 31, hh = lane >> 5;
    LAS int* lcnt = (LAS int*)(F.lds); LAS int* lbase = lcnt + 32; LAS float* red = (LAS float*)(F.lds + 4096);
    const bf16* RWF = P.RW() + (size_t)layer * 2 * 64 * 64 * 8 + lane * 8;
    f32x4 g1[4], b1[4]; load_gb(g1, b1, P.ln1_g() + (size_t)layer * D, P.ln1_b() + (size_t)layer * D, lane); bf16* XN = P.XN();
    unsigned* gcnt = F.ctl + CW_CNT + 64 * cslot;
    WfRegs Rdummy;
    for (int ch = F.vcu; ch < T / 128; ch += F.G) {
        const int m0 = ch * 128;
        if (F.tid < 64) lcnt[F.tid] = 0;
        if (MODE != 2) {
            v2u cq[4], nq[4], cm[4], nm[4]; bf16* rb = XN + (size_t)(m0 + 16 * w) * D + 4 * lane; const bf16* mb = P.MOUT() + (size_t)(m0 + 16 * w) * D + 4 * lane;
#pragma unroll
            for (int j = 0; j < 4; ++j) { cq[j] = *(const v2u*)(rb + 256 * j); cm[j] = *(const v2u*)(mb + 256 * j); }
            for (int i = 0; i < 16; ++i) {
                if (i + 1 < 16) {
#pragma unroll
                    for (int j = 0; j < 4; ++j) { nq[j] = *(const v2u*)(rb + (size_t)(i + 1) * D + 256 * j); nm[j] = *(const v2u*)(mb + (size_t)(i + 1) * D + 256 * j); } }
                f32x4 cur[4];
#pragma unroll
                for (int j = 0; j < 4; ++j) cur[j] = (f32x4){ALPHA * bflo(cq[j].x) + bflo(cm[j].x), ALPHA * bfhi(cq[j].x) + bfhi(cm[j].x), ALPHA * bflo(cq[j].y) + bflo(cm[j].y), ALPHA * bfhi(cq[j].y) + bfhi(cm[j].y)};
                finish_row<0, false>(cur, g1, b1, nullptr, XN + (size_t)(m0 + 16 * w + i) * D, Rdummy, (f32x4){0.f, 0.f, 0.f, 0.f}, nullptr, lane);
#pragma unroll
                for (int j = 0; j < 4; ++j) { cq[j] = nq[j]; cm[j] = nm[j]; } }
        }
        VM_WAIT();
        __syncthreads();
        const int tok = m0 + 32 * (w & 3) + r;
        f32x16 a0 = f32x16{}, a1 = f32x16{};
        {
            const bf16* xr = XN + (size_t)tok * D + 512 * (w >> 2) + 8 * hh;
            const bf16* wf0 = RWF + (size_t)(32 * (w >> 2)) * 512, *wf1 = wf0 + (size_t)64 * 512;
#pragma unroll 4
            for (int s = 0; s < (MODE == 1 ? 0 : 32); ++s) {
                const bf16x8 xv = *(const bf16x8*)(xr + 16 * s);
                const bf16x8 wh0 = *(const bf16x8*)(wf0 + s * 512), wh1 = *(const bf16x8*)(wf1 + s * 512);
                a0 = __builtin_amdgcn_mfma_f32_32x32x16_bf16(wh0, xv, a0, 0, 0, 0);
                a1 = __builtin_amdgcn_mfma_f32_32x32x16_bf16(wh1, xv, a1, 0, 0, 0);
            }
        }
        if (w >= 4) {
#pragma unroll
            for (int i = 0; i < 16; ++i) red[((w & 3) * 20 + i) * 64 + lane] = a0[i];
#pragma unroll
            for (int i = 0; i < 4; ++i) red[((w & 3) * 20 + 16 + i) * 64 + lane] = a1[i]; }
        __syncthreads();
        int e0 = 0, e1 = 0, rk0 = 0, rk1 = 0; float ga0 = 0.f, ga1 = 0.f;
        if (w < 4) {
#pragma unroll
            for (int i = 0; i < 16; ++i) a0[i] += red[(w * 20 + i) * 64 + lane];
#pragma unroll
            for (int i = 0; i < 4; ++i) a1[i] += red[(w * 20 + 16 + i) * 64 + lane];
            float lg[4];
#pragma unroll
            for (int i = 0; i < 4; ++i) { const float t = other_half(a1[i]); lg[i] = (hh ? t : a1[i]) + P.rgb()[layer * 4 + i]; }
            int gs = 0; float mx = lg[0];
#pragma unroll
            for (int i = 1; i < 4; ++i) if (lg[i] > mx) { mx = lg[i]; gs = i; }
            float den = 0.f;
#pragma unroll
            for (int i = 0; i < 4; ++i) den += __expf(lg[i] - mx);
            const float pg = 1.0f / den;
            float own[4], oth[4], v[8];
#pragma unroll
            for (int k = 0; k < 4; ++k) { float t = a0[k];
#pragma unroll
                for (int g = 1; g < 4; ++g) if (gs == g) t = a0[4 * g + k];
                own[k] = t; oth[k] = other_half(t); }
#pragma unroll
            for (int k = 0; k < 4; ++k) { v[k] = hh ? oth[k] : own[k]; v[4 + k] = hh ? own[k] : oth[k]; }
            float m2 = -1e30f;
#pragma unroll
            for (int k = 0; k < 8; ++k) { v[k] += P.reb()[layer * 32 + gs * 8 + k]; m2 = fmaxf(m2, v[k]); }
            float p[8], ds = 0.f;
#pragma unroll
            for (int k = 0; k < 8; ++k) { p[k] = __expf(v[k] - m2); ds += p[k]; }
            int i0 = 0; float p0 = -1.f;
#pragma unroll
            for (int k = 0; k < 8; ++k) { p[k] = p[k] / ds; if (p[k] > p0) { p0 = p[k]; i0 = k; } }
            int i1 = 0; float p1 = -1.f;
#pragma unroll
            for (int k = 0; k < 8; ++k) if (k != i0 && p[k] > p1) { p1 = p[k]; i1 = k; }
            const float sm = p0 + p1;
            e0 = gs * 8 + i0; e1 = gs * 8 + i1; ga0 = pg * p0 / sm; ga1 = pg * p1 / sm;
            if (hh == 0) { rk0 = __hip_atomic_fetch_add(lcnt + e0, 1, __ATOMIC_RELAXED, __HIP_MEMORY_SCOPE_WORKGROUP); rk1 = __hip_atomic_fetch_add(lcnt + e1, 1, __ATOMIC_RELAXED, __HIP_MEMORY_SCOPE_WORKGROUP); }
        }
        __syncthreads();
        if (F.tid < 32) { const int c = lcnt[F.tid]; lbase[F.tid] = c ? (int)__hip_atomic_fetch_add(gcnt + F.tid, (unsigned)c, RLX_AGENT) : 0; }
        __syncthreads();
        if (w < 4 && hh == 0) { const int s0 = lbase[e0] + rk0, s1 = lbase[e1] + rk1;
            P.TE()[2 * tok] = e0; P.TE()[2 * tok + 1] = e1; P.TS()[2 * tok] = s0; P.TS()[2 * tok + 1] = s1; P.TG()[2 * tok] = ga0; P.TG()[2 * tok + 1] = ga1;
            P.RT()[(size_t)e0 * ECAP + s0] = tok; P.RT()[(size_t)e1 * ECAP + s1] = tok; }
        __syncthreads();
    }
}

__device__ __forceinline__ void moe_setup(Frame& F, int cslot) {
    volatile LAS int* lc = (volatile LAS int*)(F.lds + LDSCTL_OFF);
    if (F.tid == 0) { int run = 0;
        for (int e = 0; e < NE; ++e) { const int c = (int)__hip_atomic_load(F.ctl + CW_CNT + 64 * cslot + e, RLX_AGENT); lc[LC_CNT + e] = c; lc[LC_PSTART + e] = run; run += (c + 255) >> 8; }
        lc[LC_PSTART + NE] = run; }
    __syncthreads();
}
constexpr bool MOE_HYBRID = false;
struct MoeSched {
    volatile LAS int* lc; int G, c, mode; const char* A; const char* Wt; const int* RT; unsigned* gate;
    static constexpr bool HOOKS = true;
    __device__ bool next(int i, pg8::Unit& u) const {
        const int npb = lc[LC_PSTART + NE], nu = 2 * npb, nlu = MOE_HYBRID ? nu % G : 0, nua = nu - nlu;
        int pblk, pn; u.dep = 0; u.sig = 0;
        if (mode == 0) { const int L = i * G + c; if (L >= nua) return false; pblk = L >> 1; pn = L & 1; }
        else if (mode == 1) { if (i > 0 || c >= nlu) return false; const int L = nua + c; pblk = L >> 1; pn = L & 1; u.sig = 1; }
        else { const int gh = G - nlu; const int q = (c >= nlu) ? (i < 3 ? i * gh + (c - nlu) : 3 * gh + (i - 3) * G + c) : (3 * gh + i * G + c);
            if (q >= 4 * npb) return false; pblk = q >> 2; pn = q & 3; u.dep = (2 * pblk >= nua) ? 1 : 0; }
        int e = 0; while (lc[LC_PSTART + e + 1] <= pblk) ++e;
        const int blk = pblk - lc[LC_PSTART + e];
        u.pm = pblk; u.pn = pn;
        if (mode < 2) { u.a = A; u.rows = RT + (size_t)e * ECAP + blk * 256; const int n = lc[LC_CNT + e] - blk * 256; u.nrows = n < 256 ? n : 256; u.b = Wt + ((size_t)e * 512 + pn * 256) * D * 2; }
        else { u.a = A + (size_t)pblk * 256 * DE * 2; u.rows = nullptr; u.nrows = 256; u.b = Wt + ((size_t)e * D + pn * 256) * DE * 2; }
        return true;
    }
    __device__ __forceinline__ void done(const pg8::Unit& u) const {
        if (u.sig) { asm volatile("s_waitcnt vmcnt(0)" ::: "memory");
            if ((threadIdx.x & 63) == 0) { __builtin_amdgcn_fence(__ATOMIC_RELEASE, "agent"); asm volatile("s_waitcnt vmcnt(0)" ::: "memory"); __hip_atomic_fetch_add(gate, 1u, RLX_AGENT); } }
    }
    __device__ __forceinline__ void a_ready(const pg8::Unit& u) const {
        if (u.dep) { const int npb = lc[LC_PSTART + NE], nlu = MOE_HYBRID ? (2 * npb) % G : 0; const unsigned want = 8u * (unsigned)nlu;
            unsigned spins = 0u;
            while (__hip_atomic_load(gate, RLX_AGENT) < want && ++spins < (1u << 22)) __builtin_amdgcn_s_sleep(4);
            __builtin_amdgcn_fence(__ATOMIC_ACQUIRE, "agent"); asm volatile("s_waitcnt vmcnt(0)" ::: "memory"); }
    }
};

template <bool LFL>
__device__ __forceinline__ void combine_phase(Frame& F, const Ptrs& P, int layer, float* Xo) {
    volatile LAS int* lc = (volatile LAS int*)(F.lds + LDSCTL_OFF);
    WfRegs R; if (LFL) load_wf(R, P.w_in() + (size_t)(layer + 1) * D * PWIN, F.lane);
    f32x4 g2[4], b2[4]; load_gb(g2, b2, P.ln2_g() + (size_t)layer * D, P.ln2_b() + (size_t)layer * D, F.lane); const f32x4 bf = LFL ? *(const f32x4*)(P.b_f() + (layer + 1) * 4) : (f32x4){0.f, 0.f, 0.f, 0.f};
    const int gw = F.vcu * 8 + F.wave, NGW = F.G * 8, lane = F.lane;
    const int* TE = P.TE(); const int* TS = P.TS(); const float* TG = P.TG(); const bf16* O = P.O(); bf16* XN = P.XN(); float* LF = P.LF();
    struct Meta { v2u e, s; f32x2 g; }; struct Data { v2u x[4], a[4], b[4]; };
#define LD_META(M, m) do { (M).e = *(const v2u*)(TE + 2 * (size_t)(m)); (M).s = *(const v2u*)(TS + 2 * (size_t)(m)); (M).g = *(const f32x2*)(TG + 2 * (size_t)(m)); } while (0)
#define LD_DATA(Dd, M, m) do { const size_t r0_ = (size_t)lc[LC_PSTART + (int)(M).e.x] * 256 + (M).s.x, r1_ = (size_t)lc[LC_PSTART + (int)(M).e.y] * 256 + (M).s.y; \
        _Pragma("unroll") for (int j = 0; j < 4; ++j) { (Dd).x[j] = *(const v2u*)(XN + (size_t)(m) * D + 4 * lane + 256 * j); (Dd).a[j] = *(const v2u*)(O + r0_ * D + 4 * lane + 256 * j); (Dd).b[j] = *(const v2u*)(O + r1_ * D + 4 * lane + 256 * j); } } while (0)
    Meta M0, M1, M2; Data D0, D1;
    if (gw < T) { LD_META(M0, gw); LD_DATA(D0, M0, gw); }
    if (gw + NGW < T) LD_META(M1, gw + NGW);
    for (int m = gw; m < T; m += NGW) {
        if (m + 2 * NGW < T) LD_META(M2, m + 2 * NGW);
        if (m + NGW < T) LD_DATA(D1, M1, m + NGW);
        f32x4 v[4]; const float ga0 = M0.g.x, ga1 = M0.g.y;
#pragma unroll
        for (int j = 0; j < 4; ++j) { const v2u xq = D0.x[j]; const f32x4 x = {bflo(xq.x), bfhi(xq.x), bflo(xq.y), bfhi(xq.y)}; const v2u a = D0.a[j], b = D0.b[j];
            v[j].x = ALPHA * x.x + ga0 * bflo(a.x) + ga1 * bflo(b.x); v[j].y = ALPHA * x.y + ga0 * bfhi(a.x) + ga1 * bfhi(b.x);
            v[j].z = ALPHA * x.z + ga0 * bflo(a.y) + ga1 * bflo(b.y); v[j].w = ALPHA * x.w + ga0 * bfhi(a.y) + ga1 * bfhi(b.y); }
        finish_row<LFL ? 1 : 0, !LFL, LFL>(v, g2, b2, Xo + (size_t)m * D, XN + (size_t)m * D, R, bf, LF + (size_t)m * 4, lane);
        M0 = M1; M1 = M2; D0 = D1;
    }
#undef LD_META
#undef LD_DATA
}

__global__ void __launch_bounds__(512, 2) mk_fwd(Args args) {
    extern __shared__ __attribute__((aligned(16))) unsigned char lds[];
    Frame F;
    F.lds = (LAS unsigned char*)lds; F.lds_gen = lds;
    F.MISC = (volatile LAS unsigned*)(F.lds + MISC_OFF);
    F.tid = threadIdx.x; F.lane = F.tid & 63; F.wave = __builtin_amdgcn_readfirstlane(F.tid >> 6);
    F.G = gridDim.x; { const int bx = blockIdx.x; F.vcu = (F.G % 8 == 0) ? (bx % 8) * (F.G / 8) + bx / 8 : bx; }
    F.ws = args.ws; F.X = args.out; F.ctl = (unsigned*)(args.ws + WS_CTL);
    for (int u = F.tid; u < (LDS_BYTES - LDSCTL_OFF) / 4; u += 512) ((LAS unsigned*)(F.lds + LDSCTL_OFF))[u] = 0u;
    __syncthreads();
    if (F.tid < 24) { const unsigned long long pv = (unsigned long long)args.in[F.tid]; ((LAS unsigned*)(F.lds + PTAB_OFF))[2 * F.tid] = (unsigned)pv; ((LAS unsigned*)(F.lds + PTAB_OFF))[2 * F.tid + 1] = (unsigned)(pv >> 32); }
    __syncthreads();
    Ptrs P; P.tab = (volatile LAS unsigned*)(F.lds + PTAB_OFF); P.ws = args.ws;
    XcdBarrier bar = xcd_barrier_post(F.ctl + CW_BAR, F.MISC + 8);
    const int hi = args.ph_hi; int ph = 0;
#define PHASE_END() do { ++ph; if (ph >= hi) return; xcd_barrier(bar); asm volatile("" : "+v"(F.tid)); F.lane = F.tid & 63; F.wave = __builtin_amdgcn_readfirstlane(F.tid >> 6); } while (0)

#define RUN_P0() do { p0_weights(F, P); p0_rows(F, P); } while (0)
#define RUN_G1(layer) do { for (int bh = F.G - 1 - (int)blockIdx.x; bh < NB * NH; bh += F.G) c2_scan(F, P, bh); pg8::StaticOrder So; So.init(P.XN(), P.WIN() + (size_t)(layer) * NPROJ * D, T, NPROJ, D, F.G, (int)blockIdx.x); EpiProj E{P.PROJ(), F.ctl + CW_KINF + 128 * (layer)}; \
        pg8::gemm_phase<EpiProj, pg8::StaticOrder, false>(F.lds, D, So, E, F.tid); moe_cvt_tail(F, P, layer, 0); moe_cvt_tail(F, P, layer, 1); } while (0)
#define RUN_G2(layer) do { pg8::StaticOrder So; So.init(P.MIX(), P.WOUT() + (size_t)(layer) * D * D, T, D, D, F.G, (int)blockIdx.x); EpiRes E{P.MOUT(), P.SS(), (LAS float*)(F.lds + LDSCTL_OFF + 2048)}; \
        pg8::gemm_phase<EpiRes, pg8::StaticOrder, false>(F.lds, D, So, E, F.tid); } while (0)
#define RUN_U(layer, cslot, gslot) do { moe_setup(F, cslot); MoeSched Ms{(volatile LAS int*)(F.lds + LDSCTL_OFF), F.G, F.vcu, 0, (const char*)P.XN(), (const char*)(P.W13() + (size_t)(layer) * NE * 512 * D), P.RT(), F.ctl + CW_GATE + 64 * (gslot)}; EpiSwiglu E{P.H()}; \
        pg8::gemm_phase<EpiSwiglu, MoeSched, true>(F.lds, D, Ms, E, F.tid); } while (0)
#define RUN_DN(layer, gslot) do { { MoeSched Ml{(volatile LAS int*)(F.lds + LDSCTL_OFF), F.G, F.vcu, 1, (const char*)P.XN(), (const char*)(P.W13() + (size_t)(layer) * NE * 512 * D), P.RT(), F.ctl + CW_GATE + 64 * (gslot)}; EpiSwiglu El{P.H()}; \
        pg8::gemm_phase<EpiSwiglu, MoeSched, true>(F.lds, D, Ml, El, F.tid); } \
        MoeSched Ms{(volatile LAS int*)(F.lds + LDSCTL_OFF), F.G, F.vcu, 2, (const char*)P.H(), (const char*)(P.W2() + (size_t)(layer) * NE * D * DE), nullptr, F.ctl + CW_GATE + 64 * (gslot)}; EpiBf E{P.O()}; \
        pg8::gemm_phase<EpiBf, MoeSched, false>(F.lds, DE, Ms, E, F.tid); } while (0)
    RUN_P0();
    PHASE_END();
#define LAYER_BODY(layer, LAST) do { \
        RUN_G1(layer); PHASE_END(); \
        mixer_phase(F, P, layer, layer); PHASE_END(); \
        RUN_G2(layer); PHASE_END(); \
        router_phase(F, P, layer, layer); PHASE_END(); \
        RUN_U(layer, layer, layer); PHASE_END(); \
        RUN_DN(layer, layer); PHASE_END(); \
        if (!(LAST)) { combine_phase<true>(F, P, layer, nullptr); PHASE_END(); } else combine_phase<false>(F, P, layer, F.X); } while (0)
    LAYER_BODY(0, false);
    LAYER_BODY(1, true);
#if MK_XP
    {
        float* Xd = (float*)(F.ws + WS_PROJ);
        for (int rep = 0; rep < MK_XR; ++rep) {
            const int sl = 2 + rep; PHASE_END();
            if (MK_XP & 2048) { for (int q = 0; q < 10; ++q) PHASE_END(); }
            if (MK_XP & 1) { RUN_P0(); PHASE_END(); }
            if (MK_XP & 2) { RUN_G1(1); PHASE_END(); }
            if (MK_XP & 4) { mixer_phase<MK_AMODE>(F, P, 1, sl, MK_ULO, MK_UHI); PHASE_END(); }
            if (MK_XP & 8) { norm_phase(F, P); PHASE_END(); }
            if (MK_XP & 16) { RUN_G2(1); PHASE_END(); }
            if (MK_XP & 32) { router_phase<MK_RMODE>(F, P, 1, sl); PHASE_END(); }
            if (MK_XP & 64) { RUN_U(1, 1, sl); PHASE_END(); }
            if (MK_XP & 512) { moe_setup(F, 1); MoeSched Ms{(volatile LAS int*)(F.lds + LDSCTL_OFF), F.G, F.vcu, 0, (const char*)P.XN(), (const char*)(P.W13() + (size_t)(1) * NE * 512 * D), P.RT(), F.ctl + CW_GATE + 64 * sl}; EpiNone E{(float*)P.H()};
                pg8::gemm_phase<EpiNone, MoeSched, true>(F.lds, D, Ms, E, F.tid); PHASE_END(); }
            if (MK_XP & 1024) { pg8::StaticOrder So; So.init(P.XN(), P.WIN() + (size_t)(1) * NPROJ * D, T, NPROJ, D, F.G, (int)blockIdx.x); EpiNone E{(float*)P.H()};
                pg8::gemm_phase<EpiNone, pg8::StaticOrder, false>(F.lds, D, So, E, F.tid); PHASE_END(); }
            if (MK_XP & 128) { RUN_DN(1, sl); PHASE_END(); }
            if (MK_XP & 256) { moe_setup(F, 1); combine_phase<false>(F, P, 1, Xd); }
        }
    }
#endif
#undef PHASE_END
}

extern "C" void kernel_launch(void* const* d_in, const int* in_sizes, int n_in, void* d_out, int out_size, void* d_ws, size_t ws_size, hipStream_t stream) {
    static int grid = 0;
    if (grid == 0) {
        if (n_in != 24 || out_size != T * D || ws_size < WS_END) { fprintf(stderr, "kernel_launch: unexpected problem (n_in %d out %d ws %zu)\n", n_in, out_size, ws_size); grid = -1; return; }
        int dev = 0, cus = 0;
        if (hipGetDevice(&dev) != hipSuccess || hipDeviceGetAttribute(&cus, hipDeviceAttributeMultiprocessorCount, dev) != hipSuccess) { grid = -1; return; }
        if (hipFuncSetAttribute((const void*)mk_fwd, hipFuncAttributeMaxDynamicSharedMemorySize, LDS_BYTES) != hipSuccess) { fprintf(stderr, "kernel_launch: hipFuncSetAttribute failed\n"); grid = -1; return; }
        int per_cu = 0; (void)hipOccupancyMaxActiveBlocksPerMultiprocessor(&per_cu, (const void*)mk_fwd, 512, LDS_BYTES); (void)hipGetLastError();
        if (per_cu < 1) fprintf(stderr, "kernel_launch: occupancy query says %d blocks/CU\n", per_cu);
        grid = cus;
    }
    if (grid < 0) return;
    (void)hipMemsetAsync((char*)d_ws + WS_CTL, 0, CTL_ZERO_BYTES, stream);
    Args a{};
    for (int i = 0; i < 24; ++i) a.in[i] = (const float*)d_in[i];
    a.out = (float*)d_out; a.ws = (unsigned char*)d_ws; a.ph_lo = 0; a.ph_hi = MK_PH_HI;
    hipLaunchKernelGGL(mk_fwd, dim3(grid), dim3(512), LDS_BYTES, stream, a);
#ifdef MK_DEBUG_TAIL
    MK_DEBUG_TAIL
#endif
}
```
